# Optimizing an MI355X kernel written in HIP

```python
import jax, jax.numpy as jnp
from jax import lax
import numpy as np

D_MODEL = 1024
BATCH = 16
SEQ = 2048
DEPTH = 1
DEC_BATCH = 32
DEC_SEQ = 4
PAST_LEN = 16384
PAGE_SIZE = 128

HEAD_DIM = 64
N_HEADS = 8
D_ATTN = N_HEADS * HEAD_DIM
D_CONV = D_MODEL - D_ATTN
CONV_WIDTH = 3
WINDOWS = (128, 512, 2048)
DILATIONS = (1, 4, 16)
MAX_WINDOW = max(WINDOWS)
Q_BLOCK = 128
D_IN = 3 * D_ATTN + 3 * D_CONV
D_FF = -(-8 * D_MODEL // (3 * 256)) * 256
RMS_EPS = 1e-6
ATTN_SCALE = HEAD_DIM ** -0.5
NEG_INF = -1e30

kernel_name = "hymba_longnet_shortconv_step"


def rms_norm(x, g):
    xf = x.astype(jnp.float32)
    y = xf * lax.rsqrt(jnp.mean(xf * xf, axis=-1, keepdims=True) + RMS_EPS)
    return (y * g.astype(jnp.float32)).astype(x.dtype)


def alibi_slopes():
    return jnp.exp2(-8.0 * jnp.arange(1, N_HEADS + 1, dtype=jnp.float32) / N_HEADS)


def _project(xn, w_in):
    b, t, _ = xn.shape
    z = xn @ w_in
    q, k, v, hc, gb, gc = jnp.split(
        z, [D_ATTN, 2 * D_ATTN, 3 * D_ATTN, 3 * D_ATTN + D_CONV, 3 * D_ATTN + 2 * D_CONV], axis=-1)
    heads = lambda a: a.reshape(b, t, N_HEADS, HEAD_DIM)
    return heads(q), heads(k), heads(v), hc, gb, gc


def _short_conv(u_ext, w_conv, t):
    acc = w_conv[0] * u_ext[:, 0:t]
    for i in range(1, CONV_WIDTH):
        acc = acc + w_conv[i] * u_ext[:, i:i + t]
    return acc


def _dilated_prompt(q, k, v, window, dilation, slopes):
    b, s, h, hd = q.shape
    nk = window // dilation
    n_sub = s // dilation
    nb = -(-n_sub // Q_BLOCK)
    lp = nb * Q_BLOCK

    def classes(a, front):
        a = a.reshape(b, n_sub, dilation, h, hd).transpose(0, 2, 1, 3, 4)
        return jnp.pad(a, ((0, 0), (0, 0), (front, lp - n_sub), (0, 0), (0, 0)))

    qb = classes(q, 0).reshape(b, dilation, nb, Q_BLOCK, h, hd)
    kidx = jnp.arange(nb)[:, None] * Q_BLOCK + jnp.arange(Q_BLOCK + nk)[None, :]
    kb = jnp.take(classes(k, nk), kidx, axis=2)
    vb = jnp.take(classes(v, nk), kidx, axis=2)
    s_qk = jnp.einsum('brnqhd,brnkhd->brnhqk', qb, kb) * ATTN_SCALE
    dist = jnp.arange(Q_BLOCK)[:, None] + nk - jnp.arange(Q_BLOCK + nk)[None, :]
    key_sub = kidx - nk
    valid = (dist >= 0)[None] & (dist <= nk)[None] & (key_sub >= 0)[:, None, :]
    bias = -slopes[:, None, None] * (dilation * dist).astype(jnp.float32)[None]
    s_qk = jnp.where(valid[None, None, :, None], s_qk + bias, NEG_INF)
    m = s_qk.max(-1)
    p = jnp.exp(s_qk - m[..., None])
    l = p.sum(-1)
    o = jnp.einsum('brnhqk,brnkhd->brnqhd', p, vb) / jnp.swapaxes(l, -1, -2)[..., None]

    def back(a):
        a = a.reshape((b, dilation, lp) + a.shape[4:])[:, :, :n_sub]
        return jnp.swapaxes(a, 1, 2).reshape((b, s) + a.shape[3:])

    return back(jnp.swapaxes(m, -1, -2)), back(jnp.swapaxes(l, -1, -2)), back(o)


def _dilated_sample(q, k_all, v_all, n_past, window, dilation, slopes):
    t = q.shape[1]
    nk = window // dilation
    j = jnp.arange(nk + 1)
    idx = n_past + jnp.arange(t)[:, None] - dilation * j[None, :]
    valid = idx >= 0
    idx = jnp.maximum(idx, 0)
    kg = k_all[:, idx]
    vg = v_all[:, idx]
    s_qk = (jnp.einsum('bthd,btjhd->bhtj', q, kg) * ATTN_SCALE
            - slopes[:, None, None] * (dilation * j).astype(jnp.float32))
    s_qk = jnp.where(valid, s_qk, NEG_INF)
    m = s_qk.max(-1)
    p = jnp.exp(s_qk - m[..., None])
    l = p.sum(-1)
    o = jnp.einsum('bhtj,btjhd->bthd', p, vg) / jnp.swapaxes(l, 1, 2)[..., None]
    return jnp.swapaxes(m, 1, 2), jnp.swapaxes(l, 1, 2), o


def _merge_branches(parts):
    m = jnp.stack([p[0] for p in parts])
    l = jnp.stack([p[1] for p in parts])
    o = jnp.stack([p[2] for p in parts])
    w = l * jnp.exp(m - m.max(0, keepdims=True))
    return (w[..., None] * o).sum(0) / w.sum(0)[..., None]


def _finish(x, attn_o, conv_o, w_out, norm_ffn_g, w_gate, w_up, w_down):
    b, t, _ = x.shape
    mix = jnp.concatenate([attn_o.reshape(b, t, D_ATTN).astype(x.dtype), conv_o], axis=-1)
    h = x + mix @ w_out
    hn = rms_norm(h, norm_ffn_g)
    return h + (jax.nn.silu(hn @ w_gate) * (hn @ w_up)) @ w_down


def _layer_prompt(x, norm_mix_g, w_in, w_conv, w_out, norm_ffn_g, w_gate, w_up, w_down):
    t = x.shape[1]
    xn = rms_norm(x, norm_mix_g)
    q, k, v, hc, gb, gc = _project(xn, w_in)
    slopes = alibi_slopes()
    qf, kf, vf = q.astype(jnp.float32), k.astype(jnp.float32), v.astype(jnp.float32)
    parts = [_dilated_prompt(qf, kf, vf, w, d, slopes) for w, d in zip(WINDOWS, DILATIONS)]
    attn_o = _merge_branches(parts)
    u = gc * hc
    u_ext = jnp.pad(u, ((0, 0), (CONV_WIDTH - 1, 0), (0, 0)))
    conv_o = gb * _short_conv(u_ext, w_conv, t)
    y = _finish(x, attn_o, conv_o, w_out, norm_ffn_g, w_gate, w_up, w_down)
    keep = min(MAX_WINDOW, t)
    return y, k[:, t - keep:], v[:, t - keep:], u_ext[:, -(CONV_WIDTH - 1):]


def _layer_sample(x, k_buf, v_buf, conv_buf, norm_mix_g, w_in, w_conv, w_out,
                  norm_ffn_g, w_gate, w_up, w_down):
    t = x.shape[1]
    xn = rms_norm(x, norm_mix_g)
    q, k, v, hc, gb, gc = _project(xn, w_in)
    slopes = alibi_slopes()
    n_past = k_buf.shape[1]
    k_all = jnp.concatenate([k_buf.astype(k.dtype), k], axis=1).astype(jnp.float32)
    v_all = jnp.concatenate([v_buf.astype(v.dtype), v], axis=1).astype(jnp.float32)
    qf = q.astype(jnp.float32)
    parts = [_dilated_sample(qf, k_all, v_all, n_past, w, d, slopes)
             for w, d in zip(WINDOWS, DILATIONS)]
    attn_o = _merge_branches(parts)
    u = gc * hc
    u_ext = jnp.concatenate([conv_buf.astype(u.dtype), u], axis=1)
    conv_o = gb * _short_conv(u_ext, w_conv, t)
    y = _finish(x, attn_o, conv_o, w_out, norm_ffn_g, w_gate, w_up, w_down)
    return y, k, v, u_ext[:, -(CONV_WIDTH - 1):]


def setup_inputs(seed: int = 0) -> dict:
    key = jax.random.key(seed)
    ks = jax.random.split(key, 16)
    f32 = jnp.float32
    n_buf = min(MAX_WINDOW, PAST_LEN)

    def nrm(k, shape, scale):
        return jax.random.normal(k, shape, f32) * scale

    return {
        'x_prompt': nrm(ks[0], (BATCH, SEQ, D_MODEL), 1.0),
        'x_sample': nrm(ks[1], (DEC_BATCH, DEC_SEQ, D_MODEL), 1.0),
        'state_attn_k': nrm(ks[2], (DEPTH, DEC_BATCH, n_buf, N_HEADS, HEAD_DIM), 1.0),
        'state_attn_v': nrm(ks[3], (DEPTH, DEC_BATCH, n_buf, N_HEADS, HEAD_DIM), 1.0),
        'state_conv': nrm(ks[4], (DEPTH, DEC_BATCH, CONV_WIDTH - 1, D_CONV), 1.0),
        'norm_mix_g': 1.0 + nrm(ks[5], (DEPTH, D_MODEL), 0.01),
        'w_in': nrm(ks[6], (DEPTH, D_MODEL, D_IN), D_MODEL ** -0.5),
        'w_conv': nrm(ks[7], (DEPTH, CONV_WIDTH, D_CONV), CONV_WIDTH ** -0.5),
        'w_out': nrm(ks[8], (DEPTH, D_ATTN + D_CONV, D_MODEL), (D_ATTN + D_CONV) ** -0.5),
        'norm_ffn_g': 1.0 + nrm(ks[9], (DEPTH, D_MODEL), 0.01),
        'w_gate': nrm(ks[10], (DEPTH, D_MODEL, D_FF), D_MODEL ** -0.5),
        'w_up': nrm(ks[11], (DEPTH, D_MODEL, D_FF), D_MODEL ** -0.5),
        'w_down': nrm(ks[12], (DEPTH, D_FF, D_MODEL), D_FF ** -0.5),
        'norm_final_g': 1.0 + nrm(ks[13], (D_MODEL,), 0.01),
    }


def reference(x_prompt, x_sample, state_attn_k, state_attn_v, state_conv, norm_mix_g, w_in,
              w_conv, w_out, norm_ffn_g, w_gate, w_up, w_down, norm_final_g):
    yp, ys = x_prompt, x_sample
    kp_l, vp_l, cp_l, ks_l, vs_l, cs_l = [], [], [], [], [], []
    for layer in range(DEPTH):
        yp, kp, vp, cp = _layer_prompt(yp, norm_mix_g[layer], w_in[layer], w_conv[layer],
                                       w_out[layer], norm_ffn_g[layer], w_gate[layer],
                                       w_up[layer], w_down[layer])
        ys, ks, vs, cs = _layer_sample(ys, state_attn_k[layer], state_attn_v[layer],
                                       state_conv[layer], norm_mix_g[layer], w_in[layer],
                                       w_conv[layer], w_out[layer], norm_ffn_g[layer],
                                       w_gate[layer], w_up[layer], w_down[layer])
        kp_l.append(kp); vp_l.append(vp); cp_l.append(cp)
        ks_l.append(ks); vs_l.append(vs); cs_l.append(cs)
    y_prompt = rms_norm(yp, norm_final_g)
    y_sample = rms_norm(ys, norm_final_g)
    new_k_prompt = jnp.stack(kp_l)
    new_v_prompt = jnp.stack(vp_l)
    new_conv_prompt = jnp.stack(cp_l)
    new_k_sample = jnp.stack(ks_l)
    new_v_sample = jnp.stack(vs_l)
    new_conv_sample = jnp.stack(cs_l)
    return (y_prompt, y_sample, new_k_prompt, new_v_prompt, new_conv_prompt,
            new_k_sample, new_v_sample, new_conv_sample)
```

```cpp
#include <hip/hip_runtime.h>
#include <hip/hip_cooperative_groups.h>
#include <cstdio>
#include <cstdint>
namespace cg = cooperative_groups;

constexpr int MP = 32768;
constexpr int MSR = 128;
constexpr int MV = MP + MSR;
constexpr int MT = MP + 256;
constexpr int DM = 1024, DA = 512, DIN = 3072, DFF = 2816;
constexpr float RMS_EPS = 1e-6f;
constexpr float LOG2E = 1.4426950408889634f;
constexpr float QSCALE = 0.125f * LOG2E;
constexpr size_t O_Y = 0;
constexpr size_t O_KP = (size_t)MV * DM;
constexpr size_t O_VP = O_KP + (size_t)MP * DA;
constexpr size_t O_CP = O_VP + (size_t)MP * DA;
constexpr size_t O_KS = O_CP + 16 * 2 * 512;
constexpr size_t O_VS = O_KS + (size_t)MSR * DA;
constexpr size_t O_CS = O_VS + (size_t)MSR * DA;
constexpr size_t O_END = O_CS + 32 * 2 * 512;
namespace pg8 {
#define PG8_LAS __attribute__((address_space(3)))
typedef unsigned short bf16_t;
typedef short bf16x8 __attribute__((ext_vector_type(8)));
typedef float f32x4 __attribute__((ext_vector_type(4)));
typedef unsigned u32x4 __attribute__((ext_vector_type(4)));
constexpr int BM = 256, BK = 64, HALF = 128, HTB = HALF * BK * 2  , STAGE_BYTES = 8 * HTB, NXCD = 8, WGM = 8;

__host__ __device__ __forceinline__ int lds_byte(int r, int c) { const int st = (r >> 4) * 2 + (c >> 5), rr = r & 15, cc = c & 31, ob = rr * 64 + cc * 2; return st * 1024 + (ob ^ (((ob >> 9) & 1) << 5)); }
__host__ __device__ __forceinline__ void stage_rc(int b, int& R, int& C) { const int st = b / 1024, sb = b % 1024, swz = sb ^ (((sb >> 9) & 1) << 5); R = (st >> 1) * 16 + swz / 64; C = (st & 1) * 32 + (swz % 64) / 2; }
__host__ __device__ __forceinline__ int perm32(int rho) { const int n = rho >> 4, i = rho & 15; return 8 * (i >> 2) + 4 * n + (i & 3); }

struct Unit { int pm, pn; };
struct Gemm { const bf16_t* A; const bf16_t* Bt; int M, N, K; };

struct StaticOrder {
    int nM, nN, nwg, G, c;
    __host__ __device__ void init(int M, int N, int G_, int c_) { nM = M / BM; nN = N / BM; nwg = nM * nN; G = G_; c = c_; }
    __host__ __device__ bool next(int i, Unit& u) const {
        const long L = (long)i * G + c; if (L >= nwg) return false;
        int wgid = (int)L; { const int q = nwg / NXCD, r = nwg % NXCD, xcd = wgid % NXCD, off = wgid / NXCD; wgid = (xcd < r ? xcd * (q + 1) : r * (q + 1) + (xcd - r) * q) + off; }
        const int nig = WGM * nN, gid = wgid / nig, fm = gid * WGM, gsz = (nM - fm) < WGM ? (nM - fm) : WGM;
        u.pm = fm + ((wgid % nig) % gsz); u.pn = (wgid % nig) / gsz; return true;
    }
    __device__ __forceinline__ void a_ready(const Unit&) const {}
    __device__ __forceinline__ void done(const Unit&) const {}
};

__device__ __forceinline__ unsigned cvt_pk_bf16(float lo, float hi) { unsigned r; asm volatile("v_cvt_pk_bf16_f32 %0, %1, %2" : "=v"(r) : "v"(lo), "v"(hi)); return r; }
__device__ __forceinline__ u32x4 pack8(const f32x4 a, const f32x4 b) { u32x4 w; w.x = cvt_pk_bf16(a[0], a[1]); w.y = cvt_pk_bf16(a[2], a[3]); w.z = cvt_pk_bf16(b[0], b[1]); w.w = cvt_pk_bf16(b[2], b[3]); return w; }
typedef unsigned u32x2 __attribute__((ext_vector_type(2)));
__device__ __forceinline__ u32x2 pack4(const f32x4 a) { u32x2 w; w.x = cvt_pk_bf16(a[0], a[1]); w.y = cvt_pk_bf16(a[2], a[3]); return w; }
__device__ __forceinline__ void st_nt(float* p, const f32x4 v) { __builtin_nontemporal_store(v, (f32x4*)p); }
__device__ __forceinline__ f32x4 ld_nt(const float* p) { return __builtin_nontemporal_load((const f32x4*)p); }
__device__ __forceinline__ float dot4(const f32x4 a) { return (a[0] * a[0] + a[1] * a[1]) + (a[2] * a[2] + a[3] * a[3]); }

struct EpiIn {
    static constexpr bool PERM = true, AFTER_DRAIN = false, PREFETCH = false; struct Pre {};
    bf16_t *Q, *K, *V, *U, *B; float* out;
    __device__ __forceinline__ void operator()(const f32x4 (&acc)[2][2][4][2], const Unit& u, int wr, int wc, int fr, int fq) const {
        const int row0 = u.pm * BM + wr * 64 + fr, pn = u.pn, cw = wc * 32 + 8 * fq;
#pragma unroll
        for (int ai = 0; ai < 2; ++ai)
#pragma unroll
            for (int m = 0; m < 4; ++m) {
                const int row = row0 + ai * HALF + m * 16;
                if (row >= MV) continue;
                if (pn < 2) {
#pragma unroll
                    for (int bj = 0; bj < 2; ++bj) { const int col = pn * 256 + bj * HALF + cw;
                        *(u32x4*)(Q + (size_t)row * DA + col) = pack8(acc[ai][bj][m][0] * QSCALE, acc[ai][bj][m][1] * QSCALE); }
                } else if (pn < 6) {
                    const bool isk = pn < 4; bf16_t* W = isk ? K : V;
                    float* op = out + (row < MP ? (isk ? O_KP : O_VP) + (size_t)row * DA : (isk ? O_KS : O_VS) + (size_t)(row - MP) * DA);
#pragma unroll
                    for (int bj = 0; bj < 2; ++bj) { const int col = (pn & 1) * 256 + bj * HALF + cw;
                        *(u32x4*)(W + (size_t)row * DA + col) = pack8(acc[ai][bj][m][0], acc[ai][bj][m][1]);
                        st_nt(op + col, acc[ai][bj][m][0]); st_nt(op + col + 4, acc[ai][bj][m][1]); }
                } else if (pn < 10) {
                    const int col = (pn - 6) * HALF + cw;
                    const f32x4 u0 = acc[ai][0][m][0] * acc[ai][1][m][0], u1 = acc[ai][0][m][1] * acc[ai][1][m][1];
                    *(u32x4*)(U + (size_t)row * DA + col) = pack8(u0, u1);
                    if (row < MP) { const int t = row & 2047; if (t >= 2046) { float* op = out + O_CP + (size_t)((row >> 11) * 2 + (t - 2046)) * 512 + col; *(f32x4*)op = u0; *(f32x4*)(op + 4) = u1; } }
                    else { const int rr = row - MP, i = rr & 3; if (i >= 2) { float* op = out + O_CS + (size_t)((rr >> 2) * 2 + (i - 2)) * 512 + col; *(f32x4*)op = u0; *(f32x4*)(op + 4) = u1; } }
                } else {
#pragma unroll
                    for (int bj = 0; bj < 2; ++bj) { const int col = (pn - 10) * 256 + bj * HALF + cw;
                        *(u32x4*)(B + (size_t)row * DA + col) = pack8(acc[ai][bj][m][0], acc[ai][bj][m][1]); }
                }
            }
    }
    __device__ __forceinline__ void thin(int row, int pn, int cw, const f32x4 v0, const f32x4 v1) const {
        if (pn < 2) { bf16_t* p = Q + (size_t)row * DA + pn * 256 + cw; *(u32x2*)p = pack4(v0 * QSCALE); *(u32x2*)(p + HALF) = pack4(v1 * QSCALE); }
        else if (pn < 6) { const bool isk = pn < 4; bf16_t* p = (isk ? K : V) + (size_t)row * DA + (pn & 1) * 256 + cw; *(u32x2*)p = pack4(v0); *(u32x2*)(p + HALF) = pack4(v1);
            float* op = out + (isk ? O_KS : O_VS) + (size_t)(row - MP) * DA + (pn & 1) * 256 + cw; *(f32x4*)op = v0; *(f32x4*)(op + HALF) = v1; }
        else if (pn < 10) { const int col = (pn - 6) * HALF + cw; const f32x4 uu = v0 * v1; *(u32x2*)(U + (size_t)row * DA + col) = pack4(uu);
            const int rr = row - MP, i = rr & 3; if (i >= 2) *(f32x4*)(out + O_CS + (size_t)((rr >> 2) * 2 + (i - 2)) * 512 + col) = uu; }
        else { bf16_t* p = B + (size_t)row * DA + (pn - 10) * 256 + cw; *(u32x2*)p = pack4(v0); *(u32x2*)(p + HALF) = pack4(v1); }
    }
};

#define PG8_RLX_AGENT2 __ATOMIC_RELAXED, __HIP_MEMORY_SCOPE_AGENT
__device__ __forceinline__ unsigned long long ssq_word(float sq) { return ((unsigned long long)(sq * 4294967296.0f) << 8) | 1ull; }
__device__ __forceinline__ float ssq_value(unsigned long long w) { return (float)(w >> 8) * (1.0f / 4294967296.0f); }
struct EpiOut {
    static constexpr bool PERM = true, AFTER_DRAIN = false, PREFETCH = false; struct Pre {};
    const float* xp; const float* xs; float* out; bf16_t* HG; const float* g; unsigned long long* ss;
    __device__ __forceinline__ void operator()(const f32x4 (&acc)[2][2][4][2], const Unit& u, int wr, int wc, int fr, int fq) const {
        const int row0 = u.pm * BM + wr * 64 + fr, colb = u.pn * 256 + wc * 32 + 8 * fq;
        f32x4 gv[2][2];
#pragma unroll
        for (int bj = 0; bj < 2; ++bj)
#pragma unroll
            for (int n = 0; n < 2; ++n) gv[bj][n] = *(const f32x4*)(g + colb + bj * HALF + 4 * n);
#pragma unroll
        for (int ai = 0; ai < 2; ++ai)
#pragma unroll
            for (int m = 0; m < 4; ++m) {
                const int row = row0 + ai * HALF + m * 16; const bool ok = row < MV;
                float sq = 0.f;
                if (ok) {
                    const float* xr = row < MP ? xp + (size_t)row * DM : xs + (size_t)(row - MP) * DM;
                    bf16_t* hrow = HG + (size_t)row * DM;
#pragma unroll
                    for (int bj = 0; bj < 2; ++bj) { const int col = colb + bj * HALF;
                        const f32x4 h0 = ld_nt(xr + col) + acc[ai][bj][m][0], h1 = ld_nt(xr + col + 4) + acc[ai][bj][m][1];
                        sq += dot4(h0) + dot4(h1);
                        *(u32x4*)(hrow + col) = pack8(h0 * gv[bj][0], h1 * gv[bj][1]); }
                }
                sq += __shfl_xor(sq, 16); sq += __shfl_xor(sq, 32);
                if (ok && fq == 0) (void)__hip_atomic_fetch_add(ss + row, ssq_word(sq), PG8_RLX_AGENT2);
            }
    }
    __device__ __forceinline__ void thin(int row, int pn, int cw, const f32x4 v0, const f32x4 v1) const {
        const int col = pn * 256 + cw; const float* xr = xs + (size_t)(row - MP) * DM + col; bf16_t* hrow = HG + (size_t)row * DM + col;
        const f32x4 h0 = *(const f32x4*)xr + v0, h1 = *(const f32x4*)(xr + HALF) + v1;
        *(u32x2*)hrow = pack4(h0 * *(const f32x4*)(g + col)); *(u32x2*)(hrow + HALF) = pack4(h1 * *(const f32x4*)(g + col + HALF));
        (void)__hip_atomic_fetch_add(ss + row, ssq_word(dot4(h0) + dot4(h1)), PG8_RLX_AGENT2);
    }
};

struct EpiGU {
    static constexpr bool PERM = true, AFTER_DRAIN = false, PREFETCH = true;
    struct Pre { unsigned hi[2][4]; };
    bf16_t* ACT; const unsigned long long* ss;
    __device__ __forceinline__ void prefetch(Pre& p, const Unit& u, int wr, int fr) const {
        const unsigned* w = (const unsigned*)(ss + u.pm * BM + wr * 64 + fr) + 1;
#pragma unroll
        for (int ai = 0; ai < 2; ++ai)
#pragma unroll
            for (int m = 0; m < 4; ++m) p.hi[ai][m] = w[2 * (ai * HALF + m * 16)];
    }
    __device__ __forceinline__ void operator()(const f32x4 (&acc)[2][2][4][2], const Unit& u, int wr, int wc, int fr, int fq, const Pre& p) const {
        const int row0 = u.pm * BM + wr * 64 + fr, col = u.pn * HALF + wc * 32 + 8 * fq;
#pragma unroll
        for (int ai = 0; ai < 2; ++ai)
#pragma unroll
            for (int m = 0; m < 4; ++m) {
                const int row = row0 + ai * HALF + m * 16;
                const float rs = __builtin_amdgcn_rsqf((float)p.hi[ai][m] * (1.0f / (256.0f * DM)) + RMS_EPS), rs2 = rs * rs, ce = -rs * LOG2E;
                f32x4 o[2];
#pragma unroll
                for (int n = 0; n < 2; ++n) {
                    const f32x4 gu = acc[ai][0][m][n] * acc[ai][1][m][n] * rs2, ex = acc[ai][0][m][n] * ce;
                    f32x4 ev, rv;
#pragma unroll
                    for (int e = 0; e < 4; ++e) ev[e] = __builtin_amdgcn_exp2f(ex[e]);
                    const f32x4 den = ev + 1.0f;
#pragma unroll
                    for (int e = 0; e < 4; ++e) rv[e] = __builtin_amdgcn_rcpf(den[e]);
                    o[n] = gu * rv; }
                *(u32x4*)(ACT + (size_t)row * DFF + col) = pack8(o[0], o[1]);
            }
    }
    __device__ __forceinline__ void thin(int row, int pn, int cw, const f32x4 v0, const f32x4 v1) const {
        const float rs = 1.0f / sqrtf(ssq_value(ss[row]) * (1.0f / DM) + RMS_EPS); f32x4 o;
#pragma unroll
        for (int e = 0; e < 4; ++e) { const float gt = v0[e] * rs, up = v1[e] * rs; o[e] = gt * __builtin_amdgcn_rcpf(1.0f + __builtin_amdgcn_exp2f(-gt * LOG2E)) * up; }
        *(u32x2*)(ACT + (size_t)row * DFF + pn * HALF + cw) = pack4(o);
    }
};

__device__ __forceinline__ f32x4 bf4_to_f32(const u32x2 w) { f32x4 r; r[0] = __builtin_bit_cast(float, w.x << 16); r[1] = __builtin_bit_cast(float, w.x & 0xffff0000u); r[2] = __builtin_bit_cast(float, w.y << 16); r[3] = __builtin_bit_cast(float, w.y & 0xffff0000u); return r; }
#define PG8_RLX_AGENT __ATOMIC_RELAXED, __HIP_MEMORY_SCOPE_AGENT
struct EpiDown {
    static constexpr bool PERM = true, AFTER_DRAIN = false, PREFETCH = false; struct Pre {};
    float* out; unsigned long long* ss; const bf16_t* HG; const float* g; const float* gfin;
    __device__ __forceinline__ void operator()(f32x4 (&acc)[2][2][4][2], const Unit& u, int wr, int wc, int fr, int fq) const {
        const int row0 = u.pm * BM + wr * 64 + fr, colb = u.pn * 256 + wc * 32 + 8 * fq;
        {
            f32x4 gi[2][2];
#pragma unroll
            for (int bj = 0; bj < 2; ++bj)
#pragma unroll
                for (int n = 0; n < 2; ++n) { const f32x4 gg = *(const f32x4*)(g + colb + bj * HALF + 4 * n);
#pragma unroll
                    for (int e = 0; e < 4; ++e) gi[bj][n][e] = __builtin_amdgcn_rcpf(gg[e]); }
#pragma unroll
            for (int ai = 0; ai < 2; ++ai)
#pragma unroll
                for (int m = 0; m < 4; ++m) {
                    const int row = row0 + ai * HALF + m * 16; const bf16_t* hrow = HG + (size_t)row * DM;
                    float sq = 0.f;
#pragma unroll
                    for (int bj = 0; bj < 2; ++bj) { const int col = colb + bj * HALF; const u32x4 hw = *(const u32x4*)(hrow + col);
                        const f32x4 h0 = bf4_to_f32((u32x2){hw.x, hw.y}) * gi[bj][0] + acc[ai][bj][m][0], h1 = bf4_to_f32((u32x2){hw.z, hw.w}) * gi[bj][1] + acc[ai][bj][m][1];
                        acc[ai][bj][m][0] = h0; acc[ai][bj][m][1] = h1; sq += dot4(h0) + dot4(h1); }
                    sq += __shfl_xor(sq, 16); sq += __shfl_xor(sq, 32);
                    if (fq == 0) (void)__hip_atomic_fetch_add(ss + row, ssq_word(sq), PG8_RLX_AGENT);
                }
        }
        f32x4 gf[2][2];
#pragma unroll
        for (int bj = 0; bj < 2; ++bj)
#pragma unroll
            for (int n = 0; n < 2; ++n) gf[bj][n] = *(const f32x4*)(gfin + colb + bj * HALF + 4 * n);
        unsigned long long tw[2][4];
        for (unsigned sp = 0u;; ++sp) {
            bool done = true;
#pragma unroll
            for (int ai = 0; ai < 2; ++ai)
#pragma unroll
                for (int m = 0; m < 4; ++m) { tw[ai][m] = __hip_atomic_load(ss + row0 + ai * HALF + m * 16, PG8_RLX_AGENT); done = done && ((unsigned)tw[ai][m] & 255u) >= 16u; }
            if (!__any(!done) || sp > (1u << 20)) break;
            __builtin_amdgcn_s_sleep(2);
        }
#pragma unroll
        for (int ai = 0; ai < 2; ++ai)
#pragma unroll
            for (int m = 0; m < 4; ++m) {
                const int row = row0 + ai * HALF + m * 16; float* orow = out + (size_t)row * DM;
                const float rs = 1.0f / sqrtf(ssq_value(tw[ai][m]) * (1.0f / DM) + RMS_EPS);
#pragma unroll
                for (int bj = 0; bj < 2; ++bj) { const int col = colb + bj * HALF;
                    st_nt(orow + col, acc[ai][bj][m][0] * rs * gf[bj][0]); st_nt(orow + col + 4, acc[ai][bj][m][1] * rs * gf[bj][1]); }
            }
    }
    __device__ __forceinline__ void thin(int row, int pn, int cw, const f32x4 v0, const f32x4 v1) const {
        const int col = pn * 256 + cw; float* orow = out + (size_t)row * DM + col; const bf16_t* hrow = HG + (size_t)row * DM + col;
        const f32x4 g0 = *(const f32x4*)(g + col), g1 = *(const f32x4*)(g + col + HALF);
        const f32x4 h0 = bf4_to_f32(*(const u32x2*)hrow) / g0 + v0, h1 = bf4_to_f32(*(const u32x2*)(hrow + HALF)) / g1 + v1;
        (void)__hip_atomic_fetch_add(ss + row, ssq_word(dot4(h0) + dot4(h1)), PG8_RLX_AGENT);
        const f32x4 f0 = *(const f32x4*)(gfin + col), f1 = *(const f32x4*)(gfin + col + HALF);
        unsigned long long w;
        for (unsigned sp = 0u;; ++sp) { w = __hip_atomic_load(ss + row, PG8_RLX_AGENT); if (!__any(((unsigned)w & 255u) < 128u) || sp > (1u << 20)) break; __builtin_amdgcn_s_sleep(2); }
        const float rs = 1.0f / sqrtf(ssq_value(w) * (1.0f / DM) + RMS_EPS);
        *(f32x4*)orow = h0 * rs * f0; *(f32x4*)(orow + HALF) = h1 * rs * f1;
    }
};
template <class Epi, class Sched, bool ALIGN_EPI = false, bool SP2 = false>
__device__ __forceinline__ void gemm_phase(PG8_LAS unsigned char* lds, const Gemm g, const Sched& S, const Epi& E) {
    int tid_ = threadIdx.x; asm volatile("" : "+v"(tid_));
    const int tid = tid_, wid = __builtin_amdgcn_readfirstlane(tid >> 6), lane = tid & 63, wr = wid >> 2, wc = wid & 3, fr = lane & 15, fq = lane >> 4;
    const int K = g.K, nt = K / BK;
    unsigned voffA[2], voffB[2];
#pragma unroll
    for (int i = 0; i < 2; ++i) { int R, C; stage_rc(tid * 16 + i * 8192, R, C); const int Rb = Epi::PERM ? ((R & ~31) + perm32(R & 31)) : R;
        voffA[i] = (unsigned)(R * K + C) * 2u; voffB[i] = (unsigned)(Rb * K + C) * 2u; }
    const size_t kstep = (size_t)(BK * 2);
    const size_t hstep = (size_t)HALF * K * 2;
    const size_t tstep = 2 * hstep;
    const unsigned ldsw = (unsigned)wid * 1024u;
    const int aoff = lds_byte(wr * 64 + fr, fq * 8), boff = lds_byte(wc * 32 + fr, fq * 8);
#define PG8_SA(b, h) (((b) * 2 + (h)) * HTB)
#define PG8_SB(b, h) ((4 + (b) * 2 + (h)) * HTB)
#define PG8_STAGE(bufoff, gbase, voff) do { _Pragma("unroll") for (int _i = 0; _i < 2; ++_i) \
        __builtin_amdgcn_global_load_lds((const unsigned*)((const char*)(gbase) + (voff)[_i]), (PG8_LAS unsigned*)(lds + (bufoff) + ldsw + _i * 8192), 16, 0, 0); } while (0)
#define PG8_LDA(dst, b, h) do { _Pragma("unroll") for (int m = 0; m < 4; ++m) _Pragma("unroll") for (int k = 0; k < 2; ++k) dst[m][k] = *(const PG8_LAS bf16x8*)(lds + PG8_SA(b, h) + aoff + m * 2048 + k * 1024); } while (0)
#define PG8_LDB(dst, b, h) do { _Pragma("unroll") for (int n = 0; n < 2; ++n) _Pragma("unroll") for (int k = 0; k < 2; ++k) dst[n][k] = *(const PG8_LAS bf16x8*)(lds + PG8_SB(b, h) + boff + n * 2048 + k * 1024); } while (0)
#define PG8_MMA(ai, bj, At, Bt) do { __builtin_amdgcn_s_setprio(1); _Pragma("unroll") for (int m = 0; m < 4; ++m) _Pragma("unroll") for (int n = 0; n < 2; ++n) _Pragma("unroll") for (int k = 0; k < 2; ++k) \
        acc[ai][bj][m][n] = __builtin_amdgcn_mfma_f32_16x16x32_bf16(Bt[n][k], At[m][k], acc[ai][bj][m][n], 0, 0, 0); __builtin_amdgcn_s_setprio(0); } while (0)
#define PG8_WAIT_V(n) asm volatile("s_waitcnt vmcnt(" #n ")" ::: "memory")
#define PG8_WAIT_L(n) asm volatile("s_waitcnt lgkmcnt(" #n ")" ::: "memory")
#define PG8_BAR __builtin_amdgcn_s_barrier()
#define PG8_SCHED __builtin_amdgcn_sched_barrier(0)
    Unit cur, nxt; int ui = 0;
    if (!S.next(0, cur)) return;
    f32x4 acc[2][2][4][2];
    typename Epi::Pre pre_{};
#pragma unroll
    for (int a = 0; a < 2; ++a)
#pragma unroll
        for (int b = 0; b < 2; ++b)
#pragma unroll
            for (int m = 0; m < 4; ++m)
#pragma unroll
                for (int n = 0; n < 2; ++n) acc[a][b][m][n] = (f32x4){0.f, 0.f, 0.f, 0.f};
    bf16x8 At[4][2], B0[2][2], B1[2][2];
    const char* cA = (const char*)g.A + (size_t)cur.pm * tstep; const char* cB = (const char*)g.Bt + (size_t)cur.pn * tstep;
    S.a_ready(cur);
    if constexpr (SP2) {
        PG8_STAGE(PG8_SB(0, 0), cB, voffB); PG8_STAGE(PG8_SB(0, 1), cB + hstep, voffB); PG8_STAGE(PG8_SA(0, 0), cA, voffA); PG8_STAGE(PG8_SA(0, 1), cA + hstep, voffA);
        if (wr == 1) PG8_BAR;
        PG8_WAIT_V(2); PG8_BAR;
        PG8_STAGE(PG8_SB(1, 0), cB + kstep, voffB); PG8_STAGE(PG8_SA(1, 0), cA + kstep, voffA); PG8_STAGE(PG8_SB(1, 1), cB + hstep + kstep, voffB);
        PG8_WAIT_V(6); PG8_BAR;
    } else {
        PG8_STAGE(PG8_SB(0, 0), cB, voffB); PG8_STAGE(PG8_SA(0, 0), cA, voffA); PG8_STAGE(PG8_SB(0, 1), cB + hstep, voffB); PG8_STAGE(PG8_SA(0, 1), cA + hstep, voffA);
        if (wr == 1) PG8_BAR;
        PG8_WAIT_V(4); PG8_BAR;
        PG8_STAGE(PG8_SB(1, 0), cB + kstep, voffB); PG8_STAGE(PG8_SA(1, 0), cA + kstep, voffA); PG8_STAGE(PG8_SB(1, 1), cB + hstep + kstep, voffB);
        PG8_WAIT_V(6); PG8_BAR;
    }
    for (;;) {
        const bool has_next = S.next(ui + 1, nxt);
        const char* nA = has_next ? (const char*)g.A + (size_t)nxt.pm * tstep : cA; const char* nB = has_next ? (const char*)g.Bt + (size_t)nxt.pn * tstep : cB;
        for (int t = 0; t < nt; t += 2) {
            const bool last = (t == nt - 2);
            const char* a1 = cA + (size_t)(t + 1) * kstep;
            const char* a2 = last ? nA : cA + (size_t)(t + 2) * kstep; const char* b2 = last ? nB : cB + (size_t)(t + 2) * kstep;
            const char* a3 = a2 + kstep; const char* b3 = b2 + kstep;
            if (last && has_next) S.a_ready(nxt);
            if constexpr (Epi::PREFETCH) { if (last) E.prefetch(pre_, cur, wr, fr); }
            if constexpr (SP2) {
            PG8_LDB(B0, 0, 0); PG8_LDB(B1, 0, 1); PG8_SCHED; PG8_LDA(At, 0, 0); PG8_STAGE(PG8_SA(1, 1), a1 + hstep, voffA);
            PG8_WAIT_V(8); PG8_WAIT_L(0); PG8_BAR; PG8_MMA(0, 0, At, B0); PG8_MMA(0, 1, At, B1); PG8_BAR; PG8_SCHED;
            PG8_LDA(At, 0, 1); PG8_STAGE(PG8_SB(0, 0), b2, voffB); PG8_STAGE(PG8_SB(0, 1), b2 + hstep, voffB); PG8_STAGE(PG8_SA(0, 0), a2, voffA);
            PG8_WAIT_V(8); PG8_WAIT_L(0); PG8_BAR; PG8_MMA(1, 0, At, B0); PG8_MMA(1, 1, At, B1); PG8_BAR; PG8_SCHED;
            PG8_LDB(B0, 1, 0); PG8_LDB(B1, 1, 1); PG8_SCHED; PG8_LDA(At, 1, 0); PG8_STAGE(PG8_SA(0, 1), a2 + hstep, voffA);
            PG8_WAIT_V(8); PG8_WAIT_L(0); PG8_BAR; PG8_MMA(0, 0, At, B0); PG8_MMA(0, 1, At, B1); PG8_BAR; PG8_SCHED;
            PG8_LDA(At, 1, 1); PG8_STAGE(PG8_SB(1, 0), b3, voffB); PG8_STAGE(PG8_SB(1, 1), b3 + hstep, voffB); PG8_STAGE(PG8_SA(1, 0), a3, voffA);
            PG8_WAIT_V(8); PG8_WAIT_L(0); PG8_BAR; PG8_MMA(1, 0, At, B0); PG8_MMA(1, 1, At, B1); PG8_BAR; PG8_SCHED;
            } else {
            PG8_LDB(B0, 0, 0); PG8_SCHED; PG8_LDA(At, 0, 0); PG8_STAGE(PG8_SA(1, 1), a1 + hstep, voffA);
            PG8_WAIT_L(8); PG8_BAR; PG8_WAIT_L(0); PG8_MMA(0, 0, At, B0); PG8_BAR; PG8_SCHED;
            PG8_LDB(B1, 0, 1); PG8_STAGE(PG8_SB(0, 0), b2, voffB);
            PG8_BAR; PG8_WAIT_L(0); PG8_MMA(0, 1, At, B1); PG8_BAR;
            PG8_LDA(At, 0, 1); PG8_STAGE(PG8_SA(0, 0), a2, voffA);
            PG8_BAR; PG8_WAIT_L(0); PG8_MMA(1, 0, At, B0); PG8_BAR; PG8_SCHED;
            PG8_STAGE(PG8_SB(0, 1), b2 + hstep, voffB);
            PG8_WAIT_V(6); PG8_BAR; PG8_MMA(1, 1, At, B1); PG8_BAR;
            PG8_LDB(B0, 1, 0); PG8_SCHED; PG8_LDA(At, 1, 0); PG8_STAGE(PG8_SA(0, 1), a2 + hstep, voffA);
            PG8_WAIT_L(8); PG8_BAR; PG8_WAIT_L(0); PG8_MMA(0, 0, At, B0); PG8_BAR; PG8_SCHED;
            PG8_LDB(B1, 1, 1); PG8_STAGE(PG8_SB(1, 0), b3, voffB);
            PG8_BAR; PG8_WAIT_L(0); PG8_MMA(0, 1, At, B1); PG8_BAR;
            PG8_LDA(At, 1, 1); PG8_STAGE(PG8_SA(1, 0), a3, voffA);
            PG8_BAR; PG8_WAIT_L(0); PG8_MMA(1, 0, At, B0); PG8_BAR; PG8_SCHED;
            PG8_STAGE(PG8_SB(1, 1), b3 + hstep, voffB);
            PG8_WAIT_V(6); PG8_BAR; PG8_MMA(1, 1, At, B1); PG8_BAR;
            }
        }
        if constexpr (ALIGN_EPI) { if (wr == 0) PG8_BAR; }
        if constexpr (!Epi::AFTER_DRAIN) { if constexpr (Epi::PREFETCH) E(acc, cur, wr, wc, fr, fq, pre_); else E(acc, cur, wr, wc, fr, fq); S.done(cur); }
        if (!has_next) break;
#pragma unroll
        for (int a = 0; a < 2; ++a)
#pragma unroll
            for (int b = 0; b < 2; ++b)
#pragma unroll
                for (int m = 0; m < 4; ++m)
#pragma unroll
                    for (int n = 0; n < 2; ++n) acc[a][b][m][n] = (f32x4){0.f, 0.f, 0.f, 0.f};
        cur = nxt; cA = nA; cB = nB; ++ui;
        if constexpr (ALIGN_EPI) { if (wr == 1) PG8_BAR; }
    }
    PG8_WAIT_V(0);
    if constexpr (!ALIGN_EPI) { if (wr == 0) PG8_BAR; }
    PG8_BAR;
    if constexpr (Epi::AFTER_DRAIN) { E.fused(acc, cur, wr, wc, fr, fq, lds, wid, lane); S.done(cur); }
#undef PG8_SA
#undef PG8_SB
#undef PG8_STAGE
#undef PG8_LDA
#undef PG8_LDB
#undef PG8_MMA
#undef PG8_WAIT_V
#undef PG8_WAIT_L
#undef PG8_BAR
#undef PG8_SCHED
}
}

constexpr size_t MiB = 1u << 20;
constexpr size_t WS_SS1 = 0  , WS_SS2 = 264 * 1024  , WS_BAR = 640 * 1024  , WS_CTL_BYTES = 704 * 1024;
constexpr size_t WS_WIN = 1 * MiB, WS_WOUT = 7 * MiB, WS_WGU = 9 * MiB, WS_WDN = 20 * MiB;
constexpr size_t WS_XN = 26 * MiB;
constexpr size_t WS_Q = 91 * MiB, WS_K = 124 * MiB, WS_V = 157 * MiB, WS_U = 190 * MiB, WS_B = 223 * MiB;
constexpr size_t WS_MIX = 256 * MiB;
constexpr size_t WS_ACT = 91 * MiB;
constexpr size_t WS_END = 321 * MiB;
static_assert(WS_SS1 + (size_t)MT * 8 <= WS_SS2 && WS_SS2 + (size_t)MT * 8 <= WS_BAR, "control map");
static_assert(WS_XN + (size_t)MT * DM * 2 <= WS_Q && WS_Q + (size_t)MT * DA * 2 <= WS_K && WS_MIX + (size_t)MT * DM * 2 <= WS_END && WS_ACT + (size_t)MT * DFF * 2 <= WS_END, "ws map");

constexpr int LDS_BYTES = 147456;
#define LAS __attribute__((address_space(3)))
typedef unsigned short bf16;
typedef short bf16x8 __attribute__((ext_vector_type(8)));
typedef float f32x4 __attribute__((ext_vector_type(4)));
typedef float f32x2 __attribute__((ext_vector_type(2)));
typedef float f32x16 __attribute__((ext_vector_type(16)));
typedef unsigned u32x4 __attribute__((ext_vector_type(4)));
typedef unsigned u32x2 __attribute__((ext_vector_type(2)));

__device__ __forceinline__ unsigned f2bf(float f) { unsigned u = __builtin_bit_cast(unsigned, f); return (u + 0x7fffu + ((u >> 16) & 1u)) >> 16; }
__device__ __forceinline__ unsigned pk2(float lo, float hi) { return f2bf(lo) | (f2bf(hi) << 16); }
typedef __bf16 bf16x2_t __attribute__((ext_vector_type(2)));
__device__ __forceinline__ unsigned cvtpk(float lo, float hi) { f32x2 v = {lo, hi}; bf16x2_t b = __builtin_convertvector(v, bf16x2_t); return __builtin_bit_cast(unsigned, b); }
__device__ __forceinline__ float bf2f(unsigned short x) { return __builtin_bit_cast(float, (unsigned)x << 16); }
__device__ __forceinline__ float bflo(unsigned w) { return __builtin_bit_cast(float, w << 16); }
__device__ __forceinline__ float bfhi(unsigned w) { return __builtin_bit_cast(float, w & 0xffff0000u); }
__device__ __forceinline__ float wave_sum(float v) {
#pragma unroll
    for (int o = 1; o < 64; o <<= 1) v += __shfl_xor(v, o);
    return v;
}
__device__ __forceinline__ float wave_max(float v) {
#pragma unroll
    for (int o = 1; o < 64; o <<= 1) v = fmaxf(v, __shfl_xor(v, o));
    return v;
}
#define LDS_FENCE() asm volatile("s_waitcnt lgkmcnt(0)" ::: "memory")

#define XB_TMO      128
#define XB_XCNT(j)  (256  + 64 * (j))
#define XB_XSUB(j)  (1280 + 64 * (j))
#define XB_XGEN(j)  (2304 + 64 * (j))
#define XB_TOP      3328
#define XB_TOPGEN   3392
#define XCD_BAR_WORDS 3456
#define XB_SPIN_CAP (1u << 18)

__device__ __forceinline__ unsigned xb_ld(unsigned* p)              { return __hip_atomic_load(p, __ATOMIC_RELAXED, __HIP_MEMORY_SCOPE_AGENT); }
__device__ __forceinline__ unsigned xb_add(unsigned* p, unsigned v) { return __hip_atomic_fetch_add(p, v, __ATOMIC_RELAXED, __HIP_MEMORY_SCOPE_AGENT); }
__device__ __forceinline__ unsigned xb_xcc_id() { return (unsigned)__builtin_amdgcn_s_getreg((3 << 11) | 20) & 0xFu; }
#define XB_SPIN(cond, bar) do { unsigned _sp = 0; while (cond) { __builtin_amdgcn_s_sleep(1); \
    if ((++_sp & 255u) == 0u) { if (xb_ld(&(bar)[XB_TMO])) break; if (_sp > XB_SPIN_CAP) { atomicAdd(&(bar)[XB_TMO], 1u); break; } } } } while (0)

struct XcdBarrier {
    unsigned* bar; unsigned x;
    volatile LAS unsigned* st;
};

__device__ __forceinline__ XcdBarrier xcd_barrier_post(unsigned* bar, volatile LAS unsigned* st) {
    XcdBarrier b; b.bar = bar; b.x = xb_xcc_id(); b.st = st;
    if (threadIdx.x == 0) (void)xb_add(&bar[XB_XCNT(b.x)], 1u);
    return b;
}
__device__ __forceinline__ void xcd_barrier_complete(unsigned* bar, unsigned x, unsigned& nloc, unsigned& nx) {
    const unsigned G = gridDim.x * gridDim.y * gridDim.z;
    unsigned sum, cnt, mine, sp = 0u;
    for (;;) {
        sum = 0u; cnt = 0u; mine = 0u;
#pragma unroll
        for (unsigned j = 0; j < 16; ++j) { const unsigned c = xb_ld(&bar[XB_XCNT(j)]); sum += c; cnt += (c > 0u) ? 1u : 0u; mine = (j == x) ? c : mine; }
        if (sum == G) break;
        __builtin_amdgcn_s_sleep(1);
        if ((++sp & 255u) == 0u) { if (xb_ld(&bar[XB_TMO])) break; if (sp > XB_SPIN_CAP) { atomicAdd(&bar[XB_TMO], 1u); break; } }
    }
    nloc = mine > 0u ? mine : 1u; nx = cnt > 0u ? cnt : 1u;
}

__device__ __forceinline__ void xcd_barrier(const XcdBarrier& b) {
    asm volatile("s_waitcnt vmcnt(0)" ::: "memory");
    __syncthreads();
    if (threadIdx.x == 0) {
        unsigned* bar = b.bar;
        __builtin_amdgcn_s_waitcnt(0);
        unsigned nloc = b.st[0], nx = b.st[1];
        if (nloc == 0u) { xcd_barrier_complete(bar, b.x, nloc, nx); b.st[0] = nloc; b.st[1] = nx; }
        const unsigned old = xb_add(&bar[XB_XSUB(b.x)], 1u);
        const unsigned gen = old / nloc;
        if (old + 1u == (gen + 1u) * nloc) {
            __builtin_amdgcn_fence(__ATOMIC_RELEASE, "agent");
            asm volatile("s_waitcnt vmcnt(0)" ::: "memory");
            const unsigned og = xb_add(&bar[XB_TOP], 1u);
            const unsigned tg = og / nx;
            if (og + 1u == (tg + 1u) * nx) xb_add(&bar[XB_TOPGEN], 1u);
            else XB_SPIN(xb_ld(&bar[XB_TOPGEN]) == tg, bar);
            __builtin_amdgcn_fence(__ATOMIC_ACQUIRE, "agent");
            xb_add(&bar[XB_XGEN(b.x)], 1u);
            asm volatile("s_waitcnt vmcnt(0)" ::: "memory");
        } else {
            XB_SPIN(xb_ld(&bar[XB_XGEN(b.x)]) == gen, bar);
            __builtin_amdgcn_fence(__ATOMIC_ACQUIRE, "agent");
            asm volatile("s_waitcnt vmcnt(0)" ::: "memory");
        }
    }
    __syncthreads();
}

__device__ __forceinline__ void transpose_item(const float* W, int ldw, int K, bf16* WT, int drow0, int scol0, int kb, LAS float* scr, int lane) {
    const int k0 = 64 * kb;
#pragma unroll
    for (int i = 0; i < 32; ++i) { const int kk = 2 * i + (lane >> 5); scr[kk * 33 + (lane & 31)] = W[(size_t)(k0 + kk) * ldw + scol0 + (lane & 31)]; }
    LDS_FENCE();
    const int c = lane & 7;
#pragma unroll
    for (int j = 0; j < 4; ++j) { const int n = (lane >> 3) + 8 * j; const LAS float* s = scr + (8 * c) * 33 + n;
        u32x4 o; o.x = pk2(s[0 * 33], s[1 * 33]); o.y = pk2(s[2 * 33], s[3 * 33]); o.z = pk2(s[4 * 33], s[5 * 33]); o.w = pk2(s[6 * 33], s[7 * 33]);
        *(u32x4*)(WT + (size_t)(drow0 + n) * K + k0 + 8 * c) = o; }
    LDS_FENCE();
}
__device__ __forceinline__ void rms_rows2_to_bf16(const float* xrow0, const float* xrow1, const float* g, bf16* orow0, bf16* orow1, int lane) {
    const f32x4* gr = (const f32x4*)g + lane;
    f32x4 v[2][4]; float s[2] = {0.f, 0.f};
#pragma unroll
    for (int k = 0; k < 2; ++k) { const float* xr_ = k ? xrow1 : xrow0; if (xr_) { const f32x4* xr = (const f32x4*)xr_ + lane;
#pragma unroll
        for (int j = 0; j < 4; ++j) v[k][j] = __builtin_nontemporal_load(xr + 64 * j); } }
#pragma unroll
    for (int k = 0; k < 2; ++k) { if (k ? xrow1 != nullptr : true) {
#pragma unroll
        for (int j = 0; j < 4; ++j) s[k] += (v[k][j].x * v[k][j].x + v[k][j].y * v[k][j].y) + (v[k][j].z * v[k][j].z + v[k][j].w * v[k][j].w); } }
#pragma unroll
    for (int k = 0; k < 2; ++k) { bf16* orow = k ? orow1 : orow0; if (k && !xrow1) continue;
        const float rs = 1.0f / sqrtf(wave_sum(s[k]) * (1.0f / DM) + RMS_EPS);
        unsigned long long* o8 = (unsigned long long*)orow + lane;
#pragma unroll
        for (int j = 0; j < 4; ++j) { const f32x4 gg = gr[64 * j];
            o8[64 * j] = (unsigned long long)cvtpk(v[k][j].x * rs * gg.x, v[k][j].y * rs * gg.y) | ((unsigned long long)cvtpk(v[k][j].z * rs * gg.z, v[k][j].w * rs * gg.w) << 32); } }
}

constexpr int AT_PO = 0, AT_ML = 65536, AT_VST = 69632, AT_VST_W = 9216;
__device__ __forceinline__ int po_off(int slot, int g4) { return slot * 128 + (((g4 ^ (slot ^ (slot >> 4))) & 15) << 3); }

typedef short s16x4 __attribute__((ext_vector_type(4)));
__device__ __forceinline__ s16x4 vtr(const LAS unsigned short* p) { return __builtin_bit_cast(s16x4, __builtin_amdgcn_ds_read_tr16_b64_v4i16((LAS s16x4*)p)); }
struct AtP { const bf16* Qh; const bf16* Kh; const bf16* Vh; bf16* Oh; float sl2; int st, d, c, eq0, slot0, sstride; };
__device__ __forceinline__ AtP at_params(int g, int vcu, int G, int wave, const bf16* Q, const bf16* K, const bf16* V, bf16* MIX) {
    const int ui = g / 6, n = g - 6 * ui, u = vcu + ui * G, b = u >> 5, h = (u >> 2) & 7, blk = (ui & 1) ? 3 - (u & 3) : (u & 3)  , st = n >> 1, tau = wave + 8 * (n & 1);
    const size_t rb = (size_t)b * 2048;
    AtP p; p.Qh = Q + rb * DA + h * 64; p.Kh = K + rb * DA + h * 64; p.Vh = V + rb * DA + h * 64; p.Oh = MIX + (rb + 512 * blk) * DM + h * 64;
    p.sl2 = __builtin_amdgcn_exp2f(-(float)(h + 1)) * LOG2E; p.st = st;
    if (st == 0)      { p.d = 16; p.c = tau;     p.eq0 = 32 * blk;                    p.slot0 = tau;                          p.sstride = 16; }
    else if (st == 1) { p.d = 4;  p.c = tau & 3; p.eq0 = 128 * blk + 32 * (tau >> 2); p.slot0 = (tau & 3) + 128 * (tau >> 2); p.sstride = 4; }
    else              { p.d = 1;  p.c = 0;       p.eq0 = 512 * blk + 32 * tau;        p.slot0 = 32 * tau;                     p.sstride = 1; }
    return p;
}
__device__ __forceinline__ void attn_prompt_all(LAS unsigned char* lds, int vcu, int G, const bf16* Q, const bf16* K, const bf16* V, bf16* MIX) {
    const int tid = threadIdx.x, lane = tid & 63, wave = __builtin_amdgcn_readfirstlane(tid >> 6), r32 = lane & 31, hi = lane >> 5;
    LAS unsigned short* vs = (LAS unsigned short*)(lds + AT_VST + wave * AT_VST_W);
    LAS unsigned short* ks = vs + 2304;
    LAS f32x2* ML = (LAS f32x2*)(lds + AT_ML);
    const int nunits = (512 - vcu + G - 1) / G, T = 6 * nunits;
    const int th = r32 - 4 * hi;
    bf16x8 qn[4]; u32x4 kn[4], vn[4];
#define AT_LOADQ(P) do { const bf16* qp_ = (P).Qh + (size_t)((P).c + (P).d * ((P).eq0 + r32)) * DA + 8 * hi; \
        _Pragma("unroll") for (int d0 = 0; d0 < 4; ++d0) qn[d0] = *(const bf16x8*)(qp_ + 16 * d0); } while (0)
#define AT_LOAD(P, kt) do { const int e0_ = (P).eq0 - 128 + 32 * (kt); \
        _Pragma("unroll") for (int j = 0; j < 4; ++j) { const size_t ro_ = (size_t)((P).c + (P).d * (e0_ + (lane >> 3) + 8 * j)) * DA + 8 * (lane & 7); \
            kn[j] = *(const u32x4*)((P).Kh + ro_); vn[j] = *(const u32x4*)((P).Vh + ro_); } } while (0)
    AtP nx = at_params(0, vcu, G, wave, Q, K, V, MIX);
    if (T > 0) { AT_LOADQ(nx); AT_LOAD(nx, 4); }
#pragma unroll 1
    for (int g = 0; g < T; ++g) {
        const AtP p = nx;
        bf16x8 qf[4];
#pragma unroll
        for (int d0 = 0; d0 < 4; ++d0) qf[d0] = qn[d0];
        const bool have_next = g + 1 < T;
        if (have_next) { nx = at_params(g + 1, vcu, G, wave, Q, K, V, MIX); AT_LOADQ(nx); }
        float m = -4096.0f, l = 0.f; f32x16 o0, o1;
#pragma unroll
        for (int r = 0; r < 16; ++r) { o0[r] = 0.f; o1[r] = 0.f; }
        int kt0 = (128 - p.eq0) / 32; if (kt0 < 0) kt0 = 0;
        const float sld = p.sl2 * (float)p.d;
        f32x16 cst;
#pragma unroll
        for (int r = 0; r < 16; ++r) cst[r] = sld * (float)((r & 3) + 8 * (r >> 2));
#pragma unroll 1
        for (int kt = 4; kt >= kt0; --kt) {
            LDS_FENCE();
#pragma unroll
            for (int j = 0; j < 4; ++j) { const int key = (lane >> 3) + 8 * j, vrow = (key & 0x13) | ((key & 4) << 1) | ((key & 8) >> 1);
                *(LAS u32x4*)(vs + vrow * 72 + 8 * (lane & 7)) = vn[j]; *(LAS u32x4*)(ks + key * 72 + 8 * (lane & 7)) = kn[j]; }
            if (kt > kt0) AT_LOAD(p, kt - 1); else if (have_next) AT_LOAD(nx, 4);
            LDS_FENCE();
            bf16x8 kc[4];
#pragma unroll
            for (int d0 = 0; d0 < 4; ++d0) kc[d0] = *(const LAS bf16x8*)(ks + r32 * 72 + 16 * d0 + 8 * hi);
            __builtin_amdgcn_sched_barrier(0);
            const float b0 = -sld * (float)(128 - 32 * kt + th) - m;
            f32x16 s;
#pragma unroll
            for (int r = 0; r < 16; ++r) s[r] = cst[r] + b0;
            __builtin_amdgcn_s_setprio(1);
#pragma unroll
            for (int d0 = 0; d0 < 4; ++d0) s = __builtin_amdgcn_mfma_f32_32x32x16_bf16(kc[d0], qf[d0], s, 0, 0, 0);
            __builtin_amdgcn_s_setprio(0);
            if (kt == 4) {
#pragma unroll
                for (int r = 0; r < 16; ++r) s[r] = ((r & 3) + 8 * (r >> 2) <= th) ? s[r] : -3e38f; }
            if (kt == 0) {
#pragma unroll
                for (int r = 0; r < 16; ++r) s[r] = ((r & 3) + 8 * (r >> 2) >= th) ? s[r] : -3e38f; }
            float mt = s[0];
#pragma unroll
            for (int r = 1; r < 16; ++r) mt = fmaxf(mt, s[r]);
            { auto rr = __builtin_amdgcn_permlane32_swap(__float_as_uint(mt), __float_as_uint(mt), false, false); mt = fmaxf(__uint_as_float(rr[0]), __uint_as_float(rr[1])); }
            if (__any(mt > 0.f)) {
                const float dl = fmaxf(mt, 0.f), alpha = __builtin_amdgcn_exp2f(-dl);
                m += dl; l *= alpha;
#pragma unroll
                for (int r = 0; r < 16; ++r) { s[r] -= dl; o0[r] *= alpha; o1[r] *= alpha; }
            }
            float ls = 0.f;
#pragma unroll
            for (int r = 0; r < 16; ++r) { s[r] = __builtin_amdgcn_exp2f(s[r]); ls += s[r]; }
            l += ls;
            bf16x8 pf[2];
#pragma unroll
            for (int s2 = 0; s2 < 2; ++s2) { u32x4 w; w.x = cvtpk(s[8 * s2 + 0], s[8 * s2 + 1]); w.y = cvtpk(s[8 * s2 + 2], s[8 * s2 + 3]); w.z = cvtpk(s[8 * s2 + 4], s[8 * s2 + 5]); w.w = cvtpk(s[8 * s2 + 6], s[8 * s2 + 7]);
                pf[s2] = __builtin_bit_cast(bf16x8, w); }
#pragma unroll
            for (int s2 = 0; s2 < 2; ++s2) {
                const LAS unsigned short* tb = vs + (16 * s2 + 8 * hi + ((lane & 15) >> 2)) * 72 + 16 * ((lane >> 4) & 1) + 4 * (lane & 3);
                const s16x4 a0 = vtr(tb), a1 = vtr(tb + 4 * 72), b0_ = vtr(tb + 32), b1_ = vtr(tb + 4 * 72 + 32);
                const bf16x8 v0 = __builtin_shufflevector(a0, a1, 0, 1, 2, 3, 4, 5, 6, 7), v1 = __builtin_shufflevector(b0_, b1_, 0, 1, 2, 3, 4, 5, 6, 7);
                __builtin_amdgcn_s_setprio(1);
                o0 = __builtin_amdgcn_mfma_f32_32x32x16_bf16(v0, pf[s2], o0, 0, 0, 0);
                o1 = __builtin_amdgcn_mfma_f32_32x32x16_bf16(v1, pf[s2], o1, 0, 0, 0);
                __builtin_amdgcn_s_setprio(0);
            }
        }
        { auto rr = __builtin_amdgcn_permlane32_swap(__float_as_uint(l), __float_as_uint(l), false, false); l = __uint_as_float(rr[0]) + __uint_as_float(rr[1]); }
        const int slot = p.slot0 + p.sstride * r32, st = p.st;
        float ca, cb;
        if (st == 0) { ca = 1.0f / l; cb = 0.f; if (hi == 0) ML[slot] = (f32x2){m, l}; }
        else { const f32x2 ml = ML[slot]; const float M = fmaxf(m, ml.x), e1 = __builtin_amdgcn_exp2f(m - M), wn = l * e1, wo = ml.y * __builtin_amdgcn_exp2f(ml.x - M), inv = 1.0f / (wn + wo);
            ca = e1 * inv; cb = wo * inv; LDS_FENCE(); if (hi == 0) ML[slot] = (f32x2){M, wn + wo}; }
#pragma unroll
        for (int nh = 0; nh < 2; ++nh)
#pragma unroll
            for (int rg = 0; rg < 4; ++rg) {
                const int g4 = 8 * nh + 2 * rg + hi;
                LAS u32x2* pp = (LAS u32x2*)(lds + AT_PO + po_off(slot, g4));
                float v[4];
#pragma unroll
                for (int e2 = 0; e2 < 4; ++e2) v[e2] = ca * (nh ? o1[4 * rg + e2] : o0[4 * rg + e2]);
                if (st != 0) { const u32x2 old = *pp; v[0] += cb * bflo(old.x); v[1] += cb * bfhi(old.x); v[2] += cb * bflo(old.y); v[3] += cb * bfhi(old.y); }
                u32x2 w; w.x = cvtpk(v[0], v[1]); w.y = cvtpk(v[2], v[3]);
                if (st != 2) *pp = w;
                else *(u32x2*)(p.Oh + (size_t)slot * DM + 4 * g4) = w;
            }
        if (g & 1) asm volatile("s_waitcnt lgkmcnt(0)\n\ts_barrier" ::: "memory");
    }
#undef AT_LOADQ
#undef AT_LOAD
}

__device__ __forceinline__ void attn_sample_bh(LAS unsigned char* lds, int b, int h, const bf16* Q, const float* sk, const float* sv, const float* outp, bf16* MIX) {
    LAS float* qs = (LAS float*)lds;
    LAS float* sb = qs + 256;
    LAS float* lb = sb + 4 * 388;
    LAS float* red = lb + 16;
    const int tid = threadIdx.x, lane = tid & 63, wave = tid >> 6;
    if (tid < 256) qs[tid] = bf2f(Q[(size_t)(MP + b * 4 + (tid >> 6)) * DA + h * 64 + (tid & 63)]);
    __syncthreads();
    const float sl2 = __builtin_amdgcn_exp2f(-(float)(h + 1)) * LOG2E;
    {
        const int sub = tid & 3, grp = tid >> 2;
#pragma unroll 2
        for (int pi = grp; pi < 4 * 387; pi += 128) {
            const int i = pi / 387, rem = pi - i * 387, br = rem / 129, j = rem - br * 129, d = 1 << (2 * br), idx = 2048 + i - d * j;
            const float* kr = idx < 2048 ? sk + ((size_t)(b * 2048 + idx) * 8 + h) * 64 : outp + O_KS + (size_t)(b * 4 + idx - 2048) * DA + h * 64;
            float dot = 0.f;
#pragma unroll
            for (int c4 = 0; c4 < 4; ++c4) { const f32x4 kv = *(const f32x4*)(kr + 16 * c4 + 4 * sub); const LAS float* qq = qs + i * 64 + 16 * c4 + 4 * sub;
                dot += (kv.x * qq[0] + kv.y * qq[1]) + (kv.z * qq[2] + kv.w * qq[3]); }
            dot += __shfl_xor(dot, 1); dot += __shfl_xor(dot, 2);
            if (sub == 0) sb[i * 388 + rem] = dot - sl2 * (float)(d * j);
        }
    }
    __syncthreads();
    if (wave < 4) {
        float v[7], mx = -1e30f;
#pragma unroll
        for (int k = 0; k < 7; ++k) { const int idx = lane + 64 * k; v[k] = idx < 387 ? sb[wave * 388 + idx] : -1e30f; mx = fmaxf(mx, v[k]); }
        mx = wave_max(mx); float s = 0.f;
#pragma unroll
        for (int k = 0; k < 7; ++k) { const int idx = lane + 64 * k; const float p = __builtin_amdgcn_exp2f(v[k] - mx); if (idx < 387) { sb[wave * 388 + idx] = p; s += p; } }
        s = wave_sum(s); if (lane == 0) lb[wave] = s;
    }
    __syncthreads();
    { const int i = tid >> 7, kg = (tid & 127) >> 4, ch = tid & 15; f32x4 acc = {0.f, 0.f, 0.f, 0.f};
#pragma unroll 4
      for (int jj = kg; jj < 387; jj += 8) { const int br = jj / 129, j = jj - br * 129, d = 1 << (2 * br), idx = 2048 + i - d * j;
          const float* vr = idx < 2048 ? sv + ((size_t)(b * 2048 + idx) * 8 + h) * 64 : outp + O_VS + (size_t)(b * 4 + idx - 2048) * DA + h * 64;
          const f32x4 vv = *(const f32x4*)(vr + 4 * ch); acc += vv * sb[i * 388 + jj]; }
      *(LAS f32x4*)(red + (i * 8 + kg) * 64 + 4 * ch) = acc; }
    __syncthreads();
    if (tid < 256) { const int i = tid >> 6, dd = tid & 63; float s = 0.f;
#pragma unroll
        for (int kg = 0; kg < 8; ++kg) s += red[(i * 8 + kg) * 64 + dd];
        MIX[(size_t)(MP + b * 4 + i) * DM + h * 64 + dd] = (bf16)f2bf(s / lb[i]); }
    __syncthreads();
}

__device__ __forceinline__ void unpack8(const u32x4 w, float* f) { f[0] = bflo(w.x); f[1] = bfhi(w.x); f[2] = bflo(w.y); f[3] = bfhi(w.y); f[4] = bflo(w.z); f[5] = bfhi(w.z); f[6] = bflo(w.w); f[7] = bfhi(w.w); }
__device__ __forceinline__ void conv_rows(int vb, int G, const bf16* U, const bf16* Bg, const float* wconv, const float* sconv, bf16* MIX) {
    const int tid = threadIdx.x, rsub = tid >> 6, c8 = (tid & 63) * 8;
    float w0[8], w1[8], w2[8];
#pragma unroll
    for (int e = 0; e < 8; ++e) { w0[e] = wconv[c8 + e]; w1[e] = wconv[512 + c8 + e]; w2[e] = wconv[1024 + c8 + e]; }
    for (int r = vb * 8 + rsub; r < MV; r += G * 8) {
        float u2[8], u1[8], u0[8], gb[8];
        unpack8(*(const u32x4*)(U + (size_t)r * DA + c8), u2); unpack8(*(const u32x4*)(Bg + (size_t)r * DA + c8), gb);
        int i; const float* s1 = nullptr; const float* s0 = nullptr;
        if (r < MP) i = r & 2047;
        else { const int rr = r - MP; i = rr & 3; const float* sc = sconv + (size_t)(rr >> 2) * 1024 + c8; s1 = sc + 512; s0 = sc + (i == 0 ? 0 : 512); }
        if (i >= 1) unpack8(*(const u32x4*)(U + (size_t)(r - 1) * DA + c8), u1);
        else {
#pragma unroll
            for (int e = 0; e < 8; ++e) u1[e] = s1 ? s1[e] : 0.f; }
        if (i >= 2) unpack8(*(const u32x4*)(U + (size_t)(r - 2) * DA + c8), u0);
        else {
#pragma unroll
            for (int e = 0; e < 8; ++e) u0[e] = s0 ? s0[e] : 0.f; }
        float o[8];
#pragma unroll
        for (int e = 0; e < 8; ++e) o[e] = gb[e] * (w0[e] * u0[e] + w1[e] * u1[e] + w2[e] * u2[e]);
        u32x4 w; w.x = pk2(o[0], o[1]); w.y = pk2(o[2], o[3]); w.z = pk2(o[4], o[5]); w.w = pk2(o[6], o[7]);
        *(u32x4*)(MIX + (size_t)r * DM + 512 + c8) = w;
    }
}

template <int NKS  , class Epi>
__device__ __forceinline__ void thin_gemm(LAS unsigned char* lds, int vcu, int G, const bf16* A  , const bf16* Bt, int npn, const Epi& E) {
    constexpr int K = NKS * 128;
    const int tid = threadIdx.x, lane = tid & 63, wave = __builtin_amdgcn_readfirstlane(tid >> 6), r32 = lane & 31, hi = lane >> 5;
    LAS f32x4* red = (LAS f32x4*)lds;
    for (int t = vcu; t < npn * 16; t += G) {
        const int rb = t & 3, c32 = (t >> 2) & 3, pn = t >> 4;
        const bf16* ap = A + (size_t)(32 * rb + r32) * K + wave * (NKS * 16) + 8 * hi;
        const bf16* bp = Bt + (size_t)(256 * pn + 32 * c32 + r32) * K + wave * (NKS * 16) + 8 * hi;
        f32x16 a0, a1;
#pragma unroll
        for (int r = 0; r < 16; ++r) { a0[r] = 0.f; a1[r] = 0.f; }
        constexpr int CH = (NKS == 8) ? 8 : 11;
#pragma unroll
        for (int s0 = 0; s0 < NKS; s0 += CH) {
            bf16x8 af[CH], b0[CH], b1[CH];
#pragma unroll
            for (int s = 0; s < CH; ++s) { af[s] = *(const bf16x8*)(ap + 16 * (s0 + s)); b0[s] = *(const bf16x8*)(bp + 16 * (s0 + s)); b1[s] = *(const bf16x8*)(bp + (size_t)128 * K + 16 * (s0 + s)); }
            __builtin_amdgcn_sched_barrier(0);
#pragma unroll
            for (int s = 0; s < CH; ++s) {
                a0 = __builtin_amdgcn_mfma_f32_32x32x16_bf16(b0[s], af[s], a0, 0, 0, 0);
                a1 = __builtin_amdgcn_mfma_f32_32x32x16_bf16(b1[s], af[s], a1, 0, 0, 0);
            }
            __builtin_amdgcn_sched_barrier(0);
        }
#pragma unroll
        for (int rg = 0; rg < 4; ++rg) {
            red[((wave * 2 + 0) * 4 + rg) * 64 + lane] = (f32x4){a0[4 * rg], a0[4 * rg + 1], a0[4 * rg + 2], a0[4 * rg + 3]};
            red[((wave * 2 + 1) * 4 + rg) * 64 + lane] = (f32x4){a1[4 * rg], a1[4 * rg + 1], a1[4 * rg + 2], a1[4 * rg + 3]};
        }
        __syncthreads();
        if (tid < 256) {
            const int rg = tid >> 6; f32x4 v0 = {0.f, 0.f, 0.f, 0.f}, v1 = {0.f, 0.f, 0.f, 0.f};
#pragma unroll
            for (int w = 0; w < 8; ++w) { v0 += red[((w * 2 + 0) * 4 + rg) * 64 + lane]; v1 += red[((w * 2 + 1) * 4 + rg) * 64 + lane]; }
            E.thin(MP + 32 * rb + r32, pn, 32 * c32 + 8 * rg + 4 * hi, v0, v1);
        }
        __syncthreads();
    }
}

struct Args { const float* in[14]; float* out; unsigned char* ws; };
__global__ void __launch_bounds__(512, 2) fwd_kernel(Args a) {
    extern __shared__ __attribute__((aligned(16))) unsigned char lds_raw[];
    LAS unsigned char* lds = (LAS unsigned char*)lds_raw;
    cg::grid_group grid = cg::this_grid();
    const int tid = threadIdx.x, lane = tid & 63, wave = __builtin_amdgcn_readfirstlane(tid >> 6);
    const int G = gridDim.x, bx = blockIdx.x;
    const int vcu = (G % 8 == 0) ? (bx % 8) * (G / 8) + bx / 8 : bx;
    unsigned char* ws = a.ws;
    const float* x_p = a.in[0]; const float* x_s = a.in[1]; const float* st_k = a.in[2]; const float* st_v = a.in[3]; const float* st_c = a.in[4];
    const float* g_mix = a.in[5]; const float* w_in = a.in[6]; const float* w_conv = a.in[7]; const float* w_out = a.in[8]; const float* g_ffn = a.in[9];
    const float* w_gate = a.in[10]; const float* w_up = a.in[11]; const float* w_down = a.in[12]; const float* g_fin = a.in[13];
    float* out = a.out;
    unsigned long long* ss1 = (unsigned long long*)(ws + WS_SS1); unsigned long long* ss2 = (unsigned long long*)(ws + WS_SS2);
    bf16* Win = (bf16*)(ws + WS_WIN); bf16* Wout = (bf16*)(ws + WS_WOUT); bf16* Wgu = (bf16*)(ws + WS_WGU); bf16* Wdn = (bf16*)(ws + WS_WDN);
    bf16* XN = (bf16*)(ws + WS_XN); bf16* Qb = (bf16*)(ws + WS_Q); bf16* Kb = (bf16*)(ws + WS_K); bf16* Vb = (bf16*)(ws + WS_V);
    bf16* Ub = (bf16*)(ws + WS_U); bf16* Bb = (bf16*)(ws + WS_B); bf16* MIX = (bf16*)(ws + WS_MIX); bf16* ACT = (bf16*)(ws + WS_ACT);

    volatile LAS unsigned* MISC = (volatile LAS unsigned*)(lds + LDS_BYTES - 128);
    if (tid < 32) MISC[tid] = 0u;
    __syncthreads();
    {
        LAS float* scr = (LAS float*)(lds + wave * 16384);
        const int gw = vcu * 8 + wave, NGW = G * 8;
        constexpr int I_IN = 16 * 96, I_OUT = 16 * 32, I_GU = 16 * 176, I_DN = 44 * 32, NITEMS = I_IN + I_OUT + I_GU + I_DN;
        for (int it = gw; it < NITEMS; it += NGW) {
            int r = it;
            if (r < I_IN) { const int kb = r / 96, db = r % 96, rho = 32 * db; int sc;
                if (rho < 1536) sc = rho;
                else if (rho < 2560) { const int j = (rho - 1536) >> 8, w = (rho - 1536) & 255; sc = w < 128 ? 1536 + 128 * j + w : 2560 + 128 * j + (w - 128); }
                else sc = 2048 + (rho - 2560);
                transpose_item(w_in, DIN, DM, Win, rho, sc, kb, scr, lane); continue; }
            r -= I_IN;
            if (r < I_OUT) { const int kb = r / 32, db = r % 32; transpose_item(w_out, DM, DM, Wout, 32 * db, 32 * db, kb, scr, lane); continue; }
            r -= I_OUT;
            if (r < I_GU) { const int kb = r / 176, db = r % 176, rho = 32 * db, pn = rho >> 8, w = rho & 255;
                transpose_item(w < 128 ? w_gate : w_up, DFF, DM, Wgu, rho, 128 * pn + (w & 127), kb, scr, lane); continue; }
            r -= I_GU;
            { const int kb = r / 32, db = r % 32; transpose_item(w_down, DM, DFF, Wdn, 32 * db, 32 * db, kb, scr, lane); }
        }
        for (int m = gw; m < MT; m += 2 * NGW) {
            const int m1 = m + NGW;
            const float* x0 = m < MV ? (m < MP ? x_p + (size_t)m * DM : x_s + (size_t)(m - MP) * DM) : nullptr;
            const float* x1 = m1 < MV ? (m1 < MP ? x_p + (size_t)m1 * DM : x_s + (size_t)(m1 - MP) * DM) : nullptr;
            if (x0) rms_rows2_to_bf16(x0, x1, g_mix, XN + (size_t)m * DM, XN + (size_t)m1 * DM, lane);
        }
    }
    { unsigned long long* ctl = (unsigned long long*)ws; for (int i = bx * 512 + tid; i < (int)(WS_CTL_BYTES / 8); i += G * 512) ctl[i] = 0ull; }
    __syncthreads();
    grid.sync();
    XcdBarrier bar = xcd_barrier_post((unsigned*)(ws + WS_BAR), MISC + 8);

    {
        pg8::Gemm g{XN, Win, MP, DIN, DM}; pg8::StaticOrder S; S.init(MP, DIN, G, bx);
        pg8::EpiIn E{Qb, Kb, Vb, Ub, Bb, out};
        thin_gemm<8>(lds, vcu, G, XN + (size_t)MP * DM, Win, DIN / 256, E);
        pg8::gemm_phase<pg8::EpiIn, pg8::StaticOrder, true, true>(lds, g, S, E);
    }
    xcd_barrier(bar);

    {
        if (vcu & 1) { for (int bh = vcu; bh < 256; bh += G) attn_sample_bh(lds, bh >> 3, bh & 7, Qb, st_k, st_v, out, MIX); }
        attn_prompt_all(lds, vcu, G, Qb, Kb, Vb, MIX);
        if (!(vcu & 1)) { for (int bh = vcu; bh < 256; bh += G) attn_sample_bh(lds, bh >> 3, bh & 7, Qb, st_k, st_v, out, MIX); }
        conv_rows(vcu, G, Ub, Bb, w_conv, st_c, MIX);
    }
    xcd_barrier(bar);

    {
        pg8::Gemm g{MIX, Wout, MP, DM, DM}; pg8::StaticOrder S; S.init(MP, DM, G, bx);
        pg8::EpiOut E{x_p, x_s, out, XN, g_ffn, ss1};
        thin_gemm<8>(lds, vcu, G, MIX + (size_t)MP * DM, Wout, DM / 256, E);
        pg8::gemm_phase<pg8::EpiOut, pg8::StaticOrder, true, true>(lds, g, S, E);
    }
    xcd_barrier(bar);

    {
        pg8::Gemm g{XN, Wgu, MP, 2 * DFF, DM}; pg8::StaticOrder S; S.init(MP, 2 * DFF, G, bx);
        pg8::EpiGU E{ACT, ss1};
        thin_gemm<8>(lds, vcu, G, XN + (size_t)MP * DM, Wgu, 2 * DFF / 256, E);
        pg8::gemm_phase<pg8::EpiGU, pg8::StaticOrder, true, true>(lds, g, S, E);
    }
    xcd_barrier(bar);

    {
        pg8::Gemm g{ACT, Wdn, MP, DM, DFF}; pg8::StaticOrder S; S.init(MP, DM, G, bx);
        pg8::EpiDown E{out, ss2, XN, g_ffn, g_fin};
        thin_gemm<22>(lds, vcu, G, ACT + (size_t)MP * DFF, Wdn, DM / 256, E);
        pg8::gemm_phase<pg8::EpiDown, pg8::StaticOrder, true, true>(lds, g, S, E);
    }
}

extern "C" void kernel_launch(void* const* d_in, const int* in_sizes, int n_in, void* d_out, int out_size, void* d_ws, size_t ws_size, hipStream_t stream) {
    static int grid = 0;
    if (grid == 0) {
        if (n_in != 14 || (size_t)out_size != O_END || ws_size < WS_END) { fprintf(stderr, "kernel_launch: unexpected shapes (n_in %d, out %d, ws %zu)\n", n_in, out_size, ws_size); grid = -1; return; }
        int dev = 0, cus = 0, per_cu = 0;
        hipGetDevice(&dev); hipDeviceGetAttribute(&cus, hipDeviceAttributeMultiprocessorCount, dev);
        if (hipFuncSetAttribute((const void*)fwd_kernel, hipFuncAttributeMaxDynamicSharedMemorySize, LDS_BYTES) != hipSuccess) { fprintf(stderr, "kernel_launch: hipFuncSetAttribute failed\n"); grid = -1; return; }
        if (hipOccupancyMaxActiveBlocksPerMultiprocessor(&per_cu, (const void*)fwd_kernel, 512, LDS_BYTES) != hipSuccess || per_cu < 1) { fprintf(stderr, "kernel_launch: occupancy query gave %d\n", per_cu); per_cu = 1; }
        (void)hipGetLastError();
        grid = cus * 1;
        if (grid <= 0) grid = 256;
    }
    if (grid < 0) return;
    Args a{};
    for (int i = 0; i < 14; ++i) a.in[i] = (const float*)d_in[i];
    a.out = (float*)d_out; a.ws = (unsigned char*)d_ws;
    void* args[] = {&a};
    hipError_t e = hipLaunchCooperativeKernel((const void*)fwd_kernel, dim3(grid), dim3(512), args, LDS_BYTES, stream);
    if (e != hipSuccess) fprintf(stderr, "cooperative launch failed: %s (grid %d)\n", hipGetErrorString(e), grid);
}
```

```cpp
#include <hip/hip_runtime.h>
#include <hip/hip_cooperative_groups.h>
#include <cstdio>
#include <cstdint>
namespace cg = cooperative_groups;

constexpr int MP = 32768;
constexpr int MSR = 128;
constexpr int MV = MP + MSR;
constexpr int MT = MP + 256;
constexpr int DM = 1024, DA = 512, DIN = 3072, DFF = 2816;
constexpr float RMS_EPS = 1e-6f;
constexpr float LOG2E = 1.4426950408889634f;
constexpr float QSCALE = 0.125f * LOG2E;
constexpr size_t O_Y = 0;
constexpr size_t O_KP = (size_t)MV * DM;
constexpr size_t O_VP = O_KP + (size_t)MP * DA;
constexpr size_t O_CP = O_VP + (size_t)MP * DA;
constexpr size_t O_KS = O_CP + 16 * 2 * 512;
constexpr size_t O_VS = O_KS + (size_t)MSR * DA;
constexpr size_t O_CS = O_VS + (size_t)MSR * DA;
constexpr size_t O_END = O_CS + 32 * 2 * 512;
namespace pg8 {
#define PG8_LAS __attribute__((address_space(3)))
typedef unsigned short bf16_t;
typedef short bf16x8 __attribute__((ext_vector_type(8)));
typedef float f32x4 __attribute__((ext_vector_type(4)));
typedef unsigned u32x4 __attribute__((ext_vector_type(4)));
constexpr int BM = 256, BK = 64, HALF = 128, HTB = HALF * BK * 2  , STAGE_BYTES = 8 * HTB, NXCD = 8, WGM = 8;

__host__ __device__ __forceinline__ int lds_byte(int r, int c) { const int st = (r >> 4) * 2 + (c >> 5), rr = r & 15, cc = c & 31, ob = rr * 64 + cc * 2; return st * 1024 + (ob ^ (((ob >> 9) & 1) << 5)); }
__host__ __device__ __forceinline__ void stage_rc(int b, int& R, int& C) { const int st = b / 1024, sb = b % 1024, swz = sb ^ (((sb >> 9) & 1) << 5); R = (st >> 1) * 16 + swz / 64; C = (st & 1) * 32 + (swz % 64) / 2; }
__host__ __device__ __forceinline__ int perm32(int rho) { const int n = rho >> 4, i = rho & 15; return 8 * (i >> 2) + 4 * n + (i & 3); }

struct Unit { int pm, pn; };
struct Gemm { const bf16_t* A; const bf16_t* Bt; int M, N, K; };

struct StaticOrder {
    int nM, nN, nwg, G, c;
    __host__ __device__ void init(int M, int N, int G_, int c_) { nM = M / BM; nN = N / BM; nwg = nM * nN; G = G_; c = c_; }
    __host__ __device__ bool next(int i, Unit& u) const {
        const long L = (long)i * G + c; if (L >= nwg) return false;
        int wgid = (int)L; { const int q = nwg / NXCD, r = nwg % NXCD, xcd = wgid % NXCD, off = wgid / NXCD; wgid = (xcd < r ? xcd * (q + 1) : r * (q + 1) + (xcd - r) * q) + off; }
        const int nig = WGM * nN, gid = wgid / nig, fm = gid * WGM, gsz = (nM - fm) < WGM ? (nM - fm) : WGM;
        u.pm = fm + ((wgid % nig) % gsz); u.pn = (wgid % nig) / gsz; return true;
    }
    __device__ __forceinline__ void a_ready(const Unit&) const {}
    __device__ __forceinline__ void done(const Unit&) const {}
};

__device__ __forceinline__ unsigned cvt_pk_bf16(float lo, float hi) { unsigned r; asm volatile("v_cvt_pk_bf16_f32 %0, %1, %2" : "=v"(r) : "v"(lo), "v"(hi)); return r; }
typedef __bf16 bf16x2v __attribute__((ext_vector_type(2))); typedef float f32x2v __attribute__((ext_vector_type(2)));
__device__ __forceinline__ unsigned cvt2(float lo, float hi) { f32x2v v = {lo, hi}; bf16x2v b = __builtin_convertvector(v, bf16x2v); return __builtin_bit_cast(unsigned, b); }
__device__ __forceinline__ u32x4 pack8(const f32x4 a, const f32x4 b) { u32x4 w; w.x = cvt2(a[0], a[1]); w.y = cvt2(a[2], a[3]); w.z = cvt2(b[0], b[1]); w.w = cvt2(b[2], b[3]); return w; }
typedef unsigned u32x2 __attribute__((ext_vector_type(2)));
__device__ __forceinline__ u32x2 pack4(const f32x4 a) { u32x2 w; w.x = cvt2(a[0], a[1]); w.y = cvt2(a[2], a[3]); return w; }
__device__ __forceinline__ void st_nt(float* p, const f32x4 v) { __builtin_nontemporal_store(v, (f32x4*)p); }
__device__ __forceinline__ f32x4 ld_nt(const float* p) { return __builtin_nontemporal_load((const f32x4*)p); }
__device__ __forceinline__ float dot4(const f32x4 a) { return (a[0] * a[0] + a[1] * a[1]) + (a[2] * a[2] + a[3] * a[3]); }

struct EpiIn {
    static constexpr bool PERM = true, AFTER_DRAIN = false, PREFETCH = false; struct Pre {};
    bf16_t *Q, *K, *V, *U, *B; float* out;
    __device__ __forceinline__ void operator()(const f32x4 (&acc)[2][2][4][2], const Unit& u, int wr, int wc, int fr, int fq) const {
        const int row0 = u.pm * BM + wr * 64 + fr, pn = u.pn, cw = wc * 32 + 8 * fq;
#pragma unroll
        for (int ai = 0; ai < 2; ++ai)
#pragma unroll
            for (int m = 0; m < 4; ++m) {
                const int row = row0 + ai * HALF + m * 16;
                if (row >= MV) continue;
                if (pn < 2) {
#pragma unroll
                    for (int bj = 0; bj < 2; ++bj) { const int col = pn * 256 + bj * HALF + cw;
                        *(u32x4*)(Q + (size_t)row * DA + col) = pack8(acc[ai][bj][m][0] * QSCALE, acc[ai][bj][m][1] * QSCALE); }
                } else if (pn < 6) {
                    const bool isk = pn < 4; bf16_t* W = isk ? K : V;
                    float* op = out + (row < MP ? (isk ? O_KP : O_VP) + (size_t)row * DA : (isk ? O_KS : O_VS) + (size_t)(row - MP) * DA);
#pragma unroll
                    for (int bj = 0; bj < 2; ++bj) { const int col = (pn & 1) * 256 + bj * HALF + cw;
                        *(u32x4*)(W + (size_t)row * DA + col) = pack8(acc[ai][bj][m][0], acc[ai][bj][m][1]);
                        st_nt(op + col, acc[ai][bj][m][0]); st_nt(op + col + 4, acc[ai][bj][m][1]); }
                } else if (pn < 10) {
                    const int col = (pn - 6) * HALF + cw;
                    const f32x4 u0 = acc[ai][0][m][0] * acc[ai][1][m][0], u1 = acc[ai][0][m][1] * acc[ai][1][m][1];
                    *(u32x4*)(U + (size_t)row * DA + col) = pack8(u0, u1);
                    if (row < MP) { const int t = row & 2047; if (t >= 2046) { float* op = out + O_CP + (size_t)((row >> 11) * 2 + (t - 2046)) * 512 + col; *(f32x4*)op = u0; *(f32x4*)(op + 4) = u1; } }
                    else { const int rr = row - MP, i = rr & 3; if (i >= 2) { float* op = out + O_CS + (size_t)((rr >> 2) * 2 + (i - 2)) * 512 + col; *(f32x4*)op = u0; *(f32x4*)(op + 4) = u1; } }
                } else {
#pragma unroll
                    for (int bj = 0; bj < 2; ++bj) { const int col = (pn - 10) * 256 + bj * HALF + cw;
                        *(u32x4*)(B + (size_t)row * DA + col) = pack8(acc[ai][bj][m][0], acc[ai][bj][m][1]); }
                }
            }
    }
    __device__ __forceinline__ void thin(int row, int pn, int cw, const f32x4 v0, const f32x4 v1) const {
        if (pn < 2) { bf16_t* p = Q + (size_t)row * DA + pn * 256 + cw; *(u32x2*)p = pack4(v0 * QSCALE); *(u32x2*)(p + HALF) = pack4(v1 * QSCALE); }
        else if (pn < 6) { const bool isk = pn < 4; bf16_t* p = (isk ? K : V) + (size_t)row * DA + (pn & 1) * 256 + cw; *(u32x2*)p = pack4(v0); *(u32x2*)(p + HALF) = pack4(v1);
            float* op = out + (isk ? O_KS : O_VS) + (size_t)(row - MP) * DA + (pn & 1) * 256 + cw; *(f32x4*)op = v0; *(f32x4*)(op + HALF) = v1; }
        else if (pn < 10) { const int col = (pn - 6) * HALF + cw; const f32x4 uu = v0 * v1; *(u32x2*)(U + (size_t)row * DA + col) = pack4(uu);
            const int rr = row - MP, i = rr & 3; if (i >= 2) *(f32x4*)(out + O_CS + (size_t)((rr >> 2) * 2 + (i - 2)) * 512 + col) = uu; }
        else { bf16_t* p = B + (size_t)row * DA + (pn - 10) * 256 + cw; *(u32x2*)p = pack4(v0); *(u32x2*)(p + HALF) = pack4(v1); }
    }
};

#define PG8_RLX_AGENT2 __ATOMIC_RELAXED, __HIP_MEMORY_SCOPE_AGENT
__device__ __forceinline__ unsigned long long ssq_word(float sq) { return ((unsigned long long)(sq * 4294967296.0f) << 8) | 1ull; }
__device__ __forceinline__ float ssq_value(unsigned long long w) { return (float)(w >> 8) * (1.0f / 4294967296.0f); }
struct EpiOut {
    static constexpr bool PERM = true, AFTER_DRAIN = false, PREFETCH = false; struct Pre {};
    const float* xp; const float* xs; float* out; bf16_t* HG; const float* g; unsigned long long* ss;
    __device__ __forceinline__ void operator()(const f32x4 (&acc)[2][2][4][2], const Unit& u, int wr, int wc, int fr, int fq) const {
        const int row0 = u.pm * BM + wr * 64 + fr, colb = u.pn * 256 + wc * 32 + 8 * fq;
        f32x4 gv[2][2];
#pragma unroll
        for (int bj = 0; bj < 2; ++bj)
#pragma unroll
            for (int n = 0; n < 2; ++n) gv[bj][n] = *(const f32x4*)(g + colb + bj * HALF + 4 * n);
#pragma unroll
        for (int ai = 0; ai < 2; ++ai)
#pragma unroll
            for (int m = 0; m < 4; ++m) {
                const int row = row0 + ai * HALF + m * 16; const bool ok = row < MV;
                float sq = 0.f;
                if (ok) {
                    const float* xr = row < MP ? xp + (size_t)row * DM : xs + (size_t)(row - MP) * DM;
                    bf16_t* hrow = HG + (size_t)row * DM;
#pragma unroll
                    for (int bj = 0; bj < 2; ++bj) { const int col = colb + bj * HALF;
                        const f32x4 h0 = ld_nt(xr + col) + acc[ai][bj][m][0], h1 = ld_nt(xr + col + 4) + acc[ai][bj][m][1];
                        sq += dot4(h0) + dot4(h1);
                        *(u32x4*)(hrow + col) = pack8(h0 * gv[bj][0], h1 * gv[bj][1]); }
                }
                sq += __shfl_xor(sq, 16); sq += __shfl_xor(sq, 32);
                if (ok && fq == 0) (void)__hip_atomic_fetch_add(ss + row, ssq_word(sq), PG8_RLX_AGENT2);
            }
    }
    __device__ __forceinline__ void thin(int row, int pn, int cw, const f32x4 v0, const f32x4 v1) const {
        const int col = pn * 256 + cw; const float* xr = xs + (size_t)(row - MP) * DM + col; bf16_t* hrow = HG + (size_t)row * DM + col;
        const f32x4 h0 = *(const f32x4*)xr + v0, h1 = *(const f32x4*)(xr + HALF) + v1;
        *(u32x2*)hrow = pack4(h0 * *(const f32x4*)(g + col)); *(u32x2*)(hrow + HALF) = pack4(h1 * *(const f32x4*)(g + col + HALF));
        (void)__hip_atomic_fetch_add(ss + row, ssq_word(dot4(h0) + dot4(h1)), PG8_RLX_AGENT2);
    }
};

struct EpiGU {
    static constexpr bool PERM = true, AFTER_DRAIN = false, PREFETCH = true;
    struct Pre { unsigned hi[2][4]; };
    bf16_t* ACT; const unsigned long long* ss;
    __device__ __forceinline__ void prefetch(Pre& p, const Unit& u, int wr, int fr) const {
        const unsigned* w = (const unsigned*)(ss + u.pm * BM + wr * 64 + fr) + 1;
#pragma unroll
        for (int ai = 0; ai < 2; ++ai)
#pragma unroll
            for (int m = 0; m < 4; ++m) p.hi[ai][m] = w[2 * (ai * HALF + m * 16)];
    }
    __device__ __forceinline__ void operator()(const f32x4 (&acc)[2][2][4][2], const Unit& u, int wr, int wc, int fr, int fq, const Pre& p) const {
        const int row0 = u.pm * BM + wr * 64 + fr, col = u.pn * HALF + wc * 32 + 8 * fq;
#pragma unroll
        for (int ai = 0; ai < 2; ++ai)
#pragma unroll
            for (int m = 0; m < 4; ++m) {
                const int row = row0 + ai * HALF + m * 16;
                const float rs = __builtin_amdgcn_rsqf((float)p.hi[ai][m] * (1.0f / (256.0f * DM)) + RMS_EPS), rs2 = rs * rs, ce = -rs * LOG2E;
                f32x4 o[2];
#pragma unroll
                for (int n = 0; n < 2; ++n) {
                    const f32x4 gu = acc[ai][0][m][n] * acc[ai][1][m][n] * rs2, ex = acc[ai][0][m][n] * ce;
                    f32x4 ev, rv;
#pragma unroll
                    for (int e = 0; e < 4; ++e) ev[e] = __builtin_amdgcn_exp2f(ex[e]);
                    const f32x4 den = ev + 1.0f;
#pragma unroll
                    for (int e = 0; e < 4; ++e) rv[e] = __builtin_amdgcn_rcpf(den[e]);
                    o[n] = gu * rv; }
                *(u32x4*)(ACT + (size_t)row * DFF + col) = pack8(o[0], o[1]);
            }
    }
    __device__ __forceinline__ void thin(int row, int pn, int cw, const f32x4 v0, const f32x4 v1) const {
        const float rs = 1.0f / sqrtf(ssq_value(ss[row]) * (1.0f / DM) + RMS_EPS); f32x4 o;
#pragma unroll
        for (int e = 0; e < 4; ++e) { const float gt = v0[e] * rs, up = v1[e] * rs; o[e] = gt * __builtin_amdgcn_rcpf(1.0f + __builtin_amdgcn_exp2f(-gt * LOG2E)) * up; }
        *(u32x2*)(ACT + (size_t)row * DFF + pn * HALF + cw) = pack4(o);
    }
};

__device__ __forceinline__ f32x4 bf4_to_f32(const u32x2 w) { f32x4 r; r[0] = __builtin_bit_cast(float, w.x << 16); r[1] = __builtin_bit_cast(float, w.x & 0xffff0000u); r[2] = __builtin_bit_cast(float, w.y << 16); r[3] = __builtin_bit_cast(float, w.y & 0xffff0000u); return r; }
#define PG8_RLX_AGENT __ATOMIC_RELAXED, __HIP_MEMORY_SCOPE_AGENT
struct EpiDown {
    static constexpr bool PERM = true, AFTER_DRAIN = false, PREFETCH = false; struct Pre {};
    float* out; unsigned long long* ss; const bf16_t* HG; const float* g; const float* gfin;
    __device__ __forceinline__ void operator()(f32x4 (&acc)[2][2][4][2], const Unit& u, int wr, int wc, int fr, int fq) const {
        const int row0 = u.pm * BM + wr * 64 + fr, colb = u.pn * 256 + wc * 32 + 8 * fq;
        {
            f32x4 gi[2][2];
#pragma unroll
            for (int bj = 0; bj < 2; ++bj)
#pragma unroll
                for (int n = 0; n < 2; ++n) { const f32x4 gg = *(const f32x4*)(g + colb + bj * HALF + 4 * n);
#pragma unroll
                    for (int e = 0; e < 4; ++e) gi[bj][n][e] = __builtin_amdgcn_rcpf(gg[e]); }
#pragma unroll
            for (int ai = 0; ai < 2; ++ai)
#pragma unroll
                for (int m = 0; m < 4; ++m) {
                    const int row = row0 + ai * HALF + m * 16; const bf16_t* hrow = HG + (size_t)row * DM;
                    float sq = 0.f;
#pragma unroll
                    for (int bj = 0; bj < 2; ++bj) { const int col = colb + bj * HALF; const u32x4 hw = *(const u32x4*)(hrow + col);
                        const f32x4 h0 = bf4_to_f32((u32x2){hw.x, hw.y}) * gi[bj][0] + acc[ai][bj][m][0], h1 = bf4_to_f32((u32x2){hw.z, hw.w}) * gi[bj][1] + acc[ai][bj][m][1];
                        acc[ai][bj][m][0] = h0; acc[ai][bj][m][1] = h1; sq += dot4(h0) + dot4(h1); }
                    sq += __shfl_xor(sq, 16); sq += __shfl_xor(sq, 32);
                    if (fq == 0) (void)__hip_atomic_fetch_add(ss + row, ssq_word(sq), PG8_RLX_AGENT);
                }
        }
        f32x4 gf[2][2];
#pragma unroll
        for (int bj = 0; bj < 2; ++bj)
#pragma unroll
            for (int n = 0; n < 2; ++n) gf[bj][n] = *(const f32x4*)(gfin + colb + bj * HALF + 4 * n);
        unsigned long long tw[2][4];
        for (unsigned sp = 0u;; ++sp) {
            bool done = true;
#pragma unroll
            for (int ai = 0; ai < 2; ++ai)
#pragma unroll
                for (int m = 0; m < 4; ++m) { tw[ai][m] = __hip_atomic_load(ss + row0 + ai * HALF + m * 16, PG8_RLX_AGENT); done = done && ((unsigned)tw[ai][m] & 255u) >= 16u; }
            if (!__any(!done) || sp > (1u << 20)) break;
            __builtin_amdgcn_s_sleep(2);
        }
#pragma unroll
        for (int ai = 0; ai < 2; ++ai)
#pragma unroll
            for (int m = 0; m < 4; ++m) {
                const int row = row0 + ai * HALF + m * 16; float* orow = out + (size_t)row * DM;
                const float rs = 1.0f / sqrtf(ssq_value(tw[ai][m]) * (1.0f / DM) + RMS_EPS);
#pragma unroll
                for (int bj = 0; bj < 2; ++bj) { const int col = colb + bj * HALF;
                    st_nt(orow + col, acc[ai][bj][m][0] * rs * gf[bj][0]); st_nt(orow + col + 4, acc[ai][bj][m][1] * rs * gf[bj][1]); }
            }
    }
    __device__ __forceinline__ void thin(int row, int pn, int cw, const f32x4 v0, const f32x4 v1) const {
        const int col = pn * 256 + cw; float* orow = out + (size_t)row * DM + col; const bf16_t* hrow = HG + (size_t)row * DM + col;
        const f32x4 g0 = *(const f32x4*)(g + col), g1 = *(const f32x4*)(g + col + HALF);
        const f32x4 h0 = bf4_to_f32(*(const u32x2*)hrow) / g0 + v0, h1 = bf4_to_f32(*(const u32x2*)(hrow + HALF)) / g1 + v1;
        (void)__hip_atomic_fetch_add(ss + row, ssq_word(dot4(h0) + dot4(h1)), PG8_RLX_AGENT);
        const f32x4 f0 = *(const f32x4*)(gfin + col), f1 = *(const f32x4*)(gfin + col + HALF);
        unsigned long long w;
        for (unsigned sp = 0u;; ++sp) { w = __hip_atomic_load(ss + row, PG8_RLX_AGENT); if (!__any(((unsigned)w & 255u) < 128u) || sp > (1u << 20)) break; __builtin_amdgcn_s_sleep(2); }
        const float rs = 1.0f / sqrtf(ssq_value(w) * (1.0f / DM) + RMS_EPS);
        *(f32x4*)orow = h0 * rs * f0; *(f32x4*)(orow + HALF) = h1 * rs * f1;
    }
};
template <class Epi, class Sched, bool ALIGN_EPI = false, bool SP2 = false>
__device__ __forceinline__ void gemm_phase(PG8_LAS unsigned char* lds, const Gemm g, const Sched& S, const Epi& E) {
    int tid_ = threadIdx.x; asm volatile("" : "+v"(tid_));
    const int tid = tid_, wid = __builtin_amdgcn_readfirstlane(tid >> 6), lane = tid & 63, wr = wid >> 2, wc = wid & 3, fr = lane & 15, fq = lane >> 4;
    const int K = g.K, nt = K / BK;
    unsigned voffA[2], voffB[2];
#pragma unroll
    for (int i = 0; i < 2; ++i) { int R, C; stage_rc(tid * 16 + i * 8192, R, C); const int Rb = Epi::PERM ? ((R & ~31) + perm32(R & 31)) : R;
        voffA[i] = (unsigned)(R * K + C) * 2u; voffB[i] = (unsigned)(Rb * K + C) * 2u; }
    const size_t kstep = (size_t)(BK * 2);
    const size_t hstep = (size_t)HALF * K * 2;
    const size_t tstep = 2 * hstep;
    const unsigned ldsw = (unsigned)wid * 1024u;
    const int aoff = lds_byte(wr * 64 + fr, fq * 8), boff = lds_byte(wc * 32 + fr, fq * 8);
#define PG8_SA(b, h) (((b) * 2 + (h)) * HTB)
#define PG8_SB(b, h) ((4 + (b) * 2 + (h)) * HTB)
#define PG8_STAGE(bufoff, gbase, voff) do { _Pragma("unroll") for (int _i = 0; _i < 2; ++_i) \
        __builtin_amdgcn_global_load_lds((const unsigned*)((const char*)(gbase) + (voff)[_i]), (PG8_LAS unsigned*)(lds + (bufoff) + ldsw + _i * 8192), 16, 0, 0); } while (0)
#define PG8_LDA(dst, b, h) do { _Pragma("unroll") for (int m = 0; m < 4; ++m) _Pragma("unroll") for (int k = 0; k < 2; ++k) dst[m][k] = *(const PG8_LAS bf16x8*)(lds + PG8_SA(b, h) + aoff + m * 2048 + k * 1024); } while (0)
#define PG8_LDB(dst, b, h) do { _Pragma("unroll") for (int n = 0; n < 2; ++n) _Pragma("unroll") for (int k = 0; k < 2; ++k) dst[n][k] = *(const PG8_LAS bf16x8*)(lds + PG8_SB(b, h) + boff + n * 2048 + k * 1024); } while (0)
#define PG8_MMA(ai, bj, At, Bt) do { __builtin_amdgcn_s_setprio(1); _Pragma("unroll") for (int m = 0; m < 4; ++m) _Pragma("unroll") for (int n = 0; n < 2; ++n) _Pragma("unroll") for (int k = 0; k < 2; ++k) \
        acc[ai][bj][m][n] = __builtin_amdgcn_mfma_f32_16x16x32_bf16(Bt[n][k], At[m][k], acc[ai][bj][m][n], 0, 0, 0); __builtin_amdgcn_s_setprio(0); } while (0)
#define PG8_WAIT_V(n) asm volatile("s_waitcnt vmcnt(" #n ")" ::: "memory")
#define PG8_WAIT_L(n) asm volatile("s_waitcnt lgkmcnt(" #n ")" ::: "memory")
#define PG8_BAR __builtin_amdgcn_s_barrier()
#define PG8_SCHED __builtin_amdgcn_sched_barrier(0)
    Unit cur, nxt; int ui = 0;
    if (!S.next(0, cur)) return;
    f32x4 acc[2][2][4][2];
    typename Epi::Pre pre_{};
#pragma unroll
    for (int a = 0; a < 2; ++a)
#pragma unroll
        for (int b = 0; b < 2; ++b)
#pragma unroll
            for (int m = 0; m < 4; ++m)
#pragma unroll
                for (int n = 0; n < 2; ++n) acc[a][b][m][n] = (f32x4){0.f, 0.f, 0.f, 0.f};
    bf16x8 At[4][2], B0[2][2], B1[2][2];
    const char* cA = (const char*)g.A + (size_t)cur.pm * tstep; const char* cB = (const char*)g.Bt + (size_t)cur.pn * tstep;
    S.a_ready(cur);
    if constexpr (SP2) {
        PG8_STAGE(PG8_SB(0, 0), cB, voffB); PG8_STAGE(PG8_SB(0, 1), cB + hstep, voffB); PG8_STAGE(PG8_SA(0, 0), cA, voffA); PG8_STAGE(PG8_SA(0, 1), cA + hstep, voffA);
        if (wr == 1) PG8_BAR;
        PG8_WAIT_V(2); PG8_BAR;
        PG8_STAGE(PG8_SB(1, 0), cB + kstep, voffB); PG8_STAGE(PG8_SA(1, 0), cA + kstep, voffA); PG8_STAGE(PG8_SB(1, 1), cB + hstep + kstep, voffB);
        PG8_WAIT_V(6); PG8_BAR;
    } else {
        PG8_STAGE(PG8_SB(0, 0), cB, voffB); PG8_STAGE(PG8_SA(0, 0), cA, voffA); PG8_STAGE(PG8_SB(0, 1), cB + hstep, voffB); PG8_STAGE(PG8_SA(0, 1), cA + hstep, voffA);
        if (wr == 1) PG8_BAR;
        PG8_WAIT_V(4); PG8_BAR;
        PG8_STAGE(PG8_SB(1, 0), cB + kstep, voffB); PG8_STAGE(PG8_SA(1, 0), cA + kstep, voffA); PG8_STAGE(PG8_SB(1, 1), cB + hstep + kstep, voffB);
        PG8_WAIT_V(6); PG8_BAR;
    }
    for (;;) {
        const bool has_next = S.next(ui + 1, nxt);
        const char* nA = has_next ? (const char*)g.A + (size_t)nxt.pm * tstep : cA; const char* nB = has_next ? (const char*)g.Bt + (size_t)nxt.pn * tstep : cB;
        for (int t = 0; t < nt; t += 2) {
            const bool last = (t == nt - 2);
            const char* a1 = cA + (size_t)(t + 1) * kstep;
            const char* a2 = last ? nA : cA + (size_t)(t + 2) * kstep; const char* b2 = last ? nB : cB + (size_t)(t + 2) * kstep;
            const char* a3 = a2 + kstep; const char* b3 = b2 + kstep;
            if (last && has_next) S.a_ready(nxt);
            if constexpr (Epi::PREFETCH) { if (last) E.prefetch(pre_, cur, wr, fr); }
            if constexpr (SP2) {
            PG8_LDB(B0, 0, 0); PG8_LDB(B1, 0, 1); PG8_SCHED; PG8_LDA(At, 0, 0); PG8_STAGE(PG8_SA(1, 1), a1 + hstep, voffA);
            PG8_WAIT_V(8); PG8_WAIT_L(0); PG8_BAR; PG8_MMA(0, 0, At, B0); PG8_MMA(0, 1, At, B1); PG8_BAR; PG8_SCHED;
            PG8_LDA(At, 0, 1); PG8_STAGE(PG8_SB(0, 0), b2, voffB); PG8_STAGE(PG8_SB(0, 1), b2 + hstep, voffB); PG8_STAGE(PG8_SA(0, 0), a2, voffA);
            PG8_WAIT_V(8); PG8_WAIT_L(0); PG8_BAR; PG8_MMA(1, 0, At, B0); PG8_MMA(1, 1, At, B1); PG8_BAR; PG8_SCHED;
            PG8_LDB(B0, 1, 0); PG8_LDB(B1, 1, 1); PG8_SCHED; PG8_LDA(At, 1, 0); PG8_STAGE(PG8_SA(0, 1), a2 + hstep, voffA);
            PG8_WAIT_V(8); PG8_WAIT_L(0); PG8_BAR; PG8_MMA(0, 0, At, B0); PG8_MMA(0, 1, At, B1); PG8_BAR; PG8_SCHED;
            PG8_LDA(At, 1, 1); PG8_STAGE(PG8_SB(1, 0), b3, voffB); PG8_STAGE(PG8_SB(1, 1), b3 + hstep, voffB); PG8_STAGE(PG8_SA(1, 0), a3, voffA);
            PG8_WAIT_V(8); PG8_WAIT_L(0); PG8_BAR; PG8_MMA(1, 0, At, B0); PG8_MMA(1, 1, At, B1); PG8_BAR; PG8_SCHED;
            } else {
            PG8_LDB(B0, 0, 0); PG8_SCHED; PG8_LDA(At, 0, 0); PG8_STAGE(PG8_SA(1, 1), a1 + hstep, voffA);
            PG8_WAIT_L(8); PG8_BAR; PG8_WAIT_L(0); PG8_MMA(0, 0, At, B0); PG8_BAR; PG8_SCHED;
            PG8_LDB(B1, 0, 1); PG8_STAGE(PG8_SB(0, 0), b2, voffB);
            PG8_BAR; PG8_WAIT_L(0); PG8_MMA(0, 1, At, B1); PG8_BAR;
            PG8_LDA(At, 0, 1); PG8_STAGE(PG8_SA(0, 0), a2, voffA);
            PG8_BAR; PG8_WAIT_L(0); PG8_MMA(1, 0, At, B0); PG8_BAR; PG8_SCHED;
            PG8_STAGE(PG8_SB(0, 1), b2 + hstep, voffB);
            PG8_WAIT_V(6); PG8_BAR; PG8_MMA(1, 1, At, B1); PG8_BAR;
            PG8_LDB(B0, 1, 0); PG8_SCHED; PG8_LDA(At, 1, 0); PG8_STAGE(PG8_SA(0, 1), a2 + hstep, voffA);
            PG8_WAIT_L(8); PG8_BAR; PG8_WAIT_L(0); PG8_MMA(0, 0, At, B0); PG8_BAR; PG8_SCHED;
            PG8_LDB(B1, 1, 1); PG8_STAGE(PG8_SB(1, 0), b3, voffB);
            PG8_BAR; PG8_WAIT_L(0); PG8_MMA(0, 1, At, B1); PG8_BAR;
            PG8_LDA(At, 1, 1); PG8_STAGE(PG8_SA(1, 0), a3, voffA);
            PG8_BAR; PG8_WAIT_L(0); PG8_MMA(1, 0, At, B0); PG8_BAR; PG8_SCHED;
            PG8_STAGE(PG8_SB(1, 1), b3 + hstep, voffB);
            PG8_WAIT_V(6); PG8_BAR; PG8_MMA(1, 1, At, B1); PG8_BAR;
            }
        }
        if constexpr (ALIGN_EPI) { if (wr == 0) PG8_BAR; }
        if constexpr (!Epi::AFTER_DRAIN) { if constexpr (Epi::PREFETCH) E(acc, cur, wr, wc, fr, fq, pre_); else E(acc, cur, wr, wc, fr, fq); S.done(cur); }
        if (!has_next) break;
#pragma unroll
        for (int a = 0; a < 2; ++a)
#pragma unroll
            for (int b = 0; b < 2; ++b)
#pragma unroll
                for (int m = 0; m < 4; ++m)
#pragma unroll
                    for (int n = 0; n < 2; ++n) acc[a][b][m][n] = (f32x4){0.f, 0.f, 0.f, 0.f};
        cur = nxt; cA = nA; cB = nB; ++ui;
        if constexpr (ALIGN_EPI) { if (wr == 1) PG8_BAR; }
    }
    PG8_WAIT_V(0);
    if constexpr (!ALIGN_EPI) { if (wr == 0) PG8_BAR; }
    PG8_BAR;
    if constexpr (Epi::AFTER_DRAIN) { E.fused(acc, cur, wr, wc, fr, fq, lds, wid, lane); S.done(cur); }
#undef PG8_SA
#undef PG8_SB
#undef PG8_STAGE
#undef PG8_LDA
#undef PG8_LDB
#undef PG8_MMA
#undef PG8_WAIT_V
#undef PG8_WAIT_L
#undef PG8_BAR
#undef PG8_SCHED
}
}

constexpr size_t MiB = 1u << 20;
constexpr size_t WS_SS1 = 0  , WS_SS2 = 264 * 1024  , WS_BAR = 640 * 1024  , WS_CTL_BYTES = 704 * 1024;
constexpr size_t WS_WIN = 1 * MiB, WS_WOUT = 7 * MiB, WS_WGU = 9 * MiB, WS_WDN = 20 * MiB;
constexpr size_t WS_XN = 26 * MiB;
constexpr size_t WS_Q = 91 * MiB, WS_K = 124 * MiB, WS_V = 157 * MiB, WS_U = 190 * MiB, WS_B = 223 * MiB;
constexpr size_t WS_MIX = 256 * MiB;
constexpr size_t WS_ACT = 91 * MiB;
constexpr size_t WS_END = 321 * MiB;
static_assert(WS_SS1 + (size_t)MT * 8 <= WS_SS2 && WS_SS2 + (size_t)MT * 8 <= WS_BAR, "control map");
static_assert(WS_XN + (size_t)MT * DM * 2 <= WS_Q && WS_Q + (size_t)MT * DA * 2 <= WS_K && WS_MIX + (size_t)MT * DM * 2 <= WS_END && WS_ACT + (size_t)MT * DFF * 2 <= WS_END, "ws map");

constexpr int LDS_BYTES = 147456;
#define LAS __attribute__((address_space(3)))
typedef unsigned short bf16;
typedef short bf16x8 __attribute__((ext_vector_type(8)));
typedef float f32x4 __attribute__((ext_vector_type(4)));
typedef float f32x2 __attribute__((ext_vector_type(2)));
typedef float f32x16 __attribute__((ext_vector_type(16)));
typedef unsigned u32x4 __attribute__((ext_vector_type(4)));
typedef unsigned u32x2 __attribute__((ext_vector_type(2)));

__device__ __forceinline__ unsigned f2bf(float f) { unsigned u = __builtin_bit_cast(unsigned, f); return (u + 0x7fffu + ((u >> 16) & 1u)) >> 16; }
__device__ __forceinline__ unsigned pk2(float lo, float hi) { return f2bf(lo) | (f2bf(hi) << 16); }
typedef __bf16 bf16x2_t __attribute__((ext_vector_type(2)));
__device__ __forceinline__ unsigned cvtpk(float lo, float hi) { f32x2 v = {lo, hi}; bf16x2_t b = __builtin_convertvector(v, bf16x2_t); return __builtin_bit_cast(unsigned, b); }
__device__ __forceinline__ float bf2f(unsigned short x) { return __builtin_bit_cast(float, (unsigned)x << 16); }
__device__ __forceinline__ float bflo(unsigned w) { return __builtin_bit_cast(float, w << 16); }
__device__ __forceinline__ float bfhi(unsigned w) { return __builtin_bit_cast(float, w & 0xffff0000u); }
__device__ __forceinline__ float wave_sum(float v) {
#pragma unroll
    for (int o = 1; o < 64; o <<= 1) v += __shfl_xor(v, o);
    return v;
}
__device__ __forceinline__ float wave_max(float v) {
#pragma unroll
    for (int o = 1; o < 64; o <<= 1) v = fmaxf(v, __shfl_xor(v, o));
    return v;
}
#define LDS_FENCE() asm volatile("s_waitcnt lgkmcnt(0)" ::: "memory")

#define XB_TMO      128
#define XB_XCNT(j)  (256  + 64 * (j))
#define XB_XSUB(j)  (1280 + 64 * (j))
#define XB_XGEN(j)  (2304 + 64 * (j))
#define XB_TOP      3328
#define XB_TOPGEN   3392
#define XCD_BAR_WORDS 3456
#define XB_SPIN_CAP (1u << 18)

__device__ __forceinline__ unsigned xb_ld(unsigned* p)              { return __hip_atomic_load(p, __ATOMIC_RELAXED, __HIP_MEMORY_SCOPE_AGENT); }
__device__ __forceinline__ unsigned xb_add(unsigned* p, unsigned v) { return __hip_atomic_fetch_add(p, v, __ATOMIC_RELAXED, __HIP_MEMORY_SCOPE_AGENT); }
__device__ __forceinline__ unsigned xb_xcc_id() { return (unsigned)__builtin_amdgcn_s_getreg((3 << 11) | 20) & 0xFu; }
#define XB_SPIN(cond, bar) do { unsigned _sp = 0; while (cond) { __builtin_amdgcn_s_sleep(1); \
    if ((++_sp & 255u) == 0u) { if (xb_ld(&(bar)[XB_TMO])) break; if (_sp > XB_SPIN_CAP) { atomicAdd(&(bar)[XB_TMO], 1u); break; } } } } while (0)

struct XcdBarrier {
    unsigned* bar; unsigned x;
    volatile LAS unsigned* st;
};

__device__ __forceinline__ XcdBarrier xcd_barrier_post(unsigned* bar, volatile LAS unsigned* st) {
    XcdBarrier b; b.bar = bar; b.x = xb_xcc_id(); b.st = st;
    if (threadIdx.x == 0) (void)xb_add(&bar[XB_XCNT(b.x)], 1u);
    return b;
}
__device__ __forceinline__ void xcd_barrier_complete(unsigned* bar, unsigned x, unsigned& nloc, unsigned& nx) {
    const unsigned G = gridDim.x * gridDim.y * gridDim.z;
    unsigned sum, cnt, mine, sp = 0u;
    for (;;) {
        sum = 0u; cnt = 0u; mine = 0u;
#pragma unroll
        for (unsigned j = 0; j < 16; ++j) { const unsigned c = xb_ld(&bar[XB_XCNT(j)]); sum += c; cnt += (c > 0u) ? 1u : 0u; mine = (j == x) ? c : mine; }
        if (sum == G) break;
        __builtin_amdgcn_s_sleep(1);
        if ((++sp & 255u) == 0u) { if (xb_ld(&bar[XB_TMO])) break; if (sp > XB_SPIN_CAP) { atomicAdd(&bar[XB_TMO], 1u); break; } }
    }
    nloc = mine > 0u ? mine : 1u; nx = cnt > 0u ? cnt : 1u;
}

__device__ __forceinline__ void xcd_barrier(const XcdBarrier& b) {
    asm volatile("s_waitcnt vmcnt(0)" ::: "memory");
    __syncthreads();
    if (threadIdx.x == 0) {
        unsigned* bar = b.bar;
        __builtin_amdgcn_s_waitcnt(0);
        unsigned nloc = b.st[0], nx = b.st[1];
        if (nloc == 0u) { xcd_barrier_complete(bar, b.x, nloc, nx); b.st[0] = nloc; b.st[1] = nx; }
        const unsigned old = xb_add(&bar[XB_XSUB(b.x)], 1u);
        const unsigned gen = old / nloc;
        if (old + 1u == (gen + 1u) * nloc) {
            __builtin_amdgcn_fence(__ATOMIC_RELEASE, "agent");
            asm volatile("s_waitcnt vmcnt(0)" ::: "memory");
            const unsigned og = xb_add(&bar[XB_TOP], 1u);
            const unsigned tg = og / nx;
            if (og + 1u == (tg + 1u) * nx) xb_add(&bar[XB_TOPGEN], 1u);
            else XB_SPIN(xb_ld(&bar[XB_TOPGEN]) == tg, bar);
            __builtin_amdgcn_fence(__ATOMIC_ACQUIRE, "agent");
            xb_add(&bar[XB_XGEN(b.x)], 1u);
            asm volatile("s_waitcnt vmcnt(0)" ::: "memory");
        } else {
            XB_SPIN(xb_ld(&bar[XB_XGEN(b.x)]) == gen, bar);
            __builtin_amdgcn_fence(__ATOMIC_ACQUIRE, "agent");
            asm volatile("s_waitcnt vmcnt(0)" ::: "memory");
        }
    }
    __syncthreads();
}

__device__ __forceinline__ void transpose_item(const float* W, int ldw, int K, bf16* WT, int drow0, int scol0, int kb, LAS float* scr, int lane) {
    const int k0 = 64 * kb;
#pragma unroll
    for (int i = 0; i < 32; ++i) { const int kk = 2 * i + (lane >> 5); scr[kk * 33 + (lane & 31)] = W[(size_t)(k0 + kk) * ldw + scol0 + (lane & 31)]; }
    LDS_FENCE();
    const int c = lane & 7;
#pragma unroll
    for (int j = 0; j < 4; ++j) { const int n = (lane >> 3) + 8 * j; const LAS float* s = scr + (8 * c) * 33 + n;
        u32x4 o; o.x = pk2(s[0 * 33], s[1 * 33]); o.y = pk2(s[2 * 33], s[3 * 33]); o.z = pk2(s[4 * 33], s[5 * 33]); o.w = pk2(s[6 * 33], s[7 * 33]);
        *(u32x4*)(WT + (size_t)(drow0 + n) * K + k0 + 8 * c) = o; }
    LDS_FENCE();
}
__device__ __forceinline__ void rms_rows2_to_bf16(const float* xrow0, const float* xrow1, const float* g, bf16* orow0, bf16* orow1, int lane) {
    const f32x4* gr = (const f32x4*)g + lane;
    f32x4 v[2][4]; float s[2] = {0.f, 0.f};
#pragma unroll
    for (int k = 0; k < 2; ++k) { const float* xr_ = k ? xrow1 : xrow0; if (xr_) { const f32x4* xr = (const f32x4*)xr_ + lane;
#pragma unroll
        for (int j = 0; j < 4; ++j) v[k][j] = __builtin_nontemporal_load(xr + 64 * j); } }
#pragma unroll
    for (int k = 0; k < 2; ++k) { if (k ? xrow1 != nullptr : true) {
#pragma unroll
        for (int j = 0; j < 4; ++j) s[k] += (v[k][j].x * v[k][j].x + v[k][j].y * v[k][j].y) + (v[k][j].z * v[k][j].z + v[k][j].w * v[k][j].w); } }
#pragma unroll
    for (int k = 0; k < 2; ++k) { bf16* orow = k ? orow1 : orow0; if (k && !xrow1) continue;
        const float rs = 1.0f / sqrtf(wave_sum(s[k]) * (1.0f / DM) + RMS_EPS);
        unsigned long long* o8 = (unsigned long long*)orow + lane;
#pragma unroll
        for (int j = 0; j < 4; ++j) { const f32x4 gg = gr[64 * j];
            o8[64 * j] = (unsigned long long)cvtpk(v[k][j].x * rs * gg.x, v[k][j].y * rs * gg.y) | ((unsigned long long)cvtpk(v[k][j].z * rs * gg.z, v[k][j].w * rs * gg.w) << 32); } }
}

constexpr int AT_PO = 0, AT_ML = 65536, AT_VST = 69632, AT_VST_W = 9216;
__device__ __forceinline__ int po_off(int slot, int g4) { return slot * 128 + (((g4 ^ (slot ^ (slot >> 4))) & 15) << 3); }

typedef short s16x4 __attribute__((ext_vector_type(4)));
__device__ __forceinline__ s16x4 vtr(const LAS unsigned short* p) { return __builtin_bit_cast(s16x4, __builtin_amdgcn_ds_read_tr16_b64_v4i16((LAS s16x4*)p)); }
struct AtP { const bf16* Qh; const bf16* Kh; const bf16* Vh; bf16* Oh; float sl2; int st, d, c, eq0, slot0, sstride; };
__device__ __forceinline__ AtP at_params(int g, int vcu, int G, int wave, const bf16* Q, const bf16* K, const bf16* V, bf16* MIX) {
    const int ui = g / 6, n = g - 6 * ui, u = vcu + ui * G, b = u >> 5, h = (u >> 2) & 7, blk = (ui & 1) ? 3 - (u & 3) : (u & 3)  , st = n >> 1, tau = wave + 8 * (n & 1);
    const size_t rb = (size_t)b * 2048;
    AtP p; p.Qh = Q + rb * DA + h * 64; p.Kh = K + rb * DA + h * 64; p.Vh = V + rb * DA + h * 64; p.Oh = MIX + (rb + 512 * blk) * DM + h * 64;
    p.sl2 = __builtin_amdgcn_exp2f(-(float)(h + 1)) * LOG2E; p.st = st;
    if (st == 0)      { p.d = 16; p.c = tau;     p.eq0 = 32 * blk;                    p.slot0 = tau;                          p.sstride = 16; }
    else if (st == 1) { p.d = 4;  p.c = tau & 3; p.eq0 = 128 * blk + 32 * (tau >> 2); p.slot0 = (tau & 3) + 128 * (tau >> 2); p.sstride = 4; }
    else              { p.d = 1;  p.c = 0;       p.eq0 = 512 * blk + 32 * tau;        p.slot0 = 32 * tau;                     p.sstride = 1; }
    return p;
}
__device__ __forceinline__ void attn_prompt_all(LAS unsigned char* lds, int vcu, int G, const bf16* Q, const bf16* K, const bf16* V, bf16* MIX) {
    const int tid = threadIdx.x, lane = tid & 63, wave = __builtin_amdgcn_readfirstlane(tid >> 6), r32 = lane & 31, hi = lane >> 5;
    LAS unsigned short* vs = (LAS unsigned short*)(lds + AT_VST + wave * AT_VST_W);
    LAS unsigned short* ks = vs + 2304;
    LAS f32x2* ML = (LAS f32x2*)(lds + AT_ML);
    const int nunits = (512 - vcu + G - 1) / G, T = 6 * nunits;
    const int th = r32 - 4 * hi;
    bf16x8 qn[4]; u32x4 kn[4], vn[4];
#define AT_LOADQ(P) do { const bf16* qp_ = (P).Qh + (size_t)((P).c + (P).d * ((P).eq0 + r32)) * DA + 8 * hi; \
        _Pragma("unroll") for (int d0 = 0; d0 < 4; ++d0) qn[d0] = *(const bf16x8*)(qp_ + 16 * d0); } while (0)
#define AT_LOAD(P, kt) do { const int e0_ = (P).eq0 - 128 + 32 * (kt); \
        _Pragma("unroll") for (int j = 0; j < 4; ++j) { const size_t ro_ = (size_t)((P).c + (P).d * (e0_ + (lane >> 3) + 8 * j)) * DA + 8 * (lane & 7); \
            kn[j] = *(const u32x4*)((P).Kh + ro_); vn[j] = *(const u32x4*)((P).Vh + ro_); } } while (0)
    AtP nx = at_params(0, vcu, G, wave, Q, K, V, MIX);
    if (T > 0) { AT_LOADQ(nx); AT_LOAD(nx, 4); }
#pragma unroll 1
    for (int g = 0; g < T; ++g) {
        const AtP p = nx;
        bf16x8 qf[4];
#pragma unroll
        for (int d0 = 0; d0 < 4; ++d0) qf[d0] = qn[d0];
        const bool have_next = g + 1 < T;
        if (have_next) { nx = at_params(g + 1, vcu, G, wave, Q, K, V, MIX); AT_LOADQ(nx); }
        float m = -4096.0f, l = 0.f; f32x16 o0, o1;
#pragma unroll
        for (int r = 0; r < 16; ++r) { o0[r] = 0.f; o1[r] = 0.f; }
        int kt0 = (128 - p.eq0) / 32; if (kt0 < 0) kt0 = 0;
        const float sld = p.sl2 * (float)p.d;
        f32x16 cst;
#pragma unroll
        for (int r = 0; r < 16; ++r) cst[r] = sld * (float)((r & 3) + 8 * (r >> 2));
#pragma unroll 1
        for (int kt = 4; kt >= kt0; --kt) {
            LDS_FENCE();
#pragma unroll
            for (int j = 0; j < 4; ++j) { const int key = (lane >> 3) + 8 * j, vrow = (key & 0x13) | ((key & 4) << 1) | ((key & 8) >> 1);
                *(LAS u32x4*)(vs + vrow * 72 + 8 * (lane & 7)) = vn[j]; *(LAS u32x4*)(ks + key * 72 + 8 * (lane & 7)) = kn[j]; }
            if (kt > kt0) AT_LOAD(p, kt - 1); else if (have_next) AT_LOAD(nx, 4);
            LDS_FENCE();
            bf16x8 kc[4];
#pragma unroll
            for (int d0 = 0; d0 < 4; ++d0) kc[d0] = *(const LAS bf16x8*)(ks + r32 * 72 + 16 * d0 + 8 * hi);
            __builtin_amdgcn_sched_barrier(0);
            const float b0 = -sld * (float)(128 - 32 * kt + th) - m;
            f32x16 s;
#pragma unroll
            for (int r = 0; r < 16; ++r) s[r] = cst[r] + b0;
            __builtin_amdgcn_s_setprio(1);
#pragma unroll
            for (int d0 = 0; d0 < 4; ++d0) s = __builtin_amdgcn_mfma_f32_32x32x16_bf16(kc[d0], qf[d0], s, 0, 0, 0);
            __builtin_amdgcn_s_setprio(0);
            if (kt == 4) {
#pragma unroll
                for (int r = 0; r < 16; ++r) s[r] = ((r & 3) + 8 * (r >> 2) <= th) ? s[r] : -3e38f; }
            if (kt == 0) {
#pragma unroll
                for (int r = 0; r < 16; ++r) s[r] = ((r & 3) + 8 * (r >> 2) >= th) ? s[r] : -3e38f; }
            float mt = s[0];
#pragma unroll
            for (int r = 1; r < 16; ++r) mt = fmaxf(mt, s[r]);
            { auto rr = __builtin_amdgcn_permlane32_swap(__float_as_uint(mt), __float_as_uint(mt), false, false); mt = fmaxf(__uint_as_float(rr[0]), __uint_as_float(rr[1])); }
            if (__any(mt > 0.f)) {
                const float dl = fmaxf(mt, 0.f), alpha = __builtin_amdgcn_exp2f(-dl);
                m += dl; l *= alpha;
#pragma unroll
                for (int r = 0; r < 16; ++r) { s[r] -= dl; o0[r] *= alpha; o1[r] *= alpha; }
            }
            float ls = 0.f;
#pragma unroll
            for (int r = 0; r < 16; ++r) { s[r] = __builtin_amdgcn_exp2f(s[r]); ls += s[r]; }
            l += ls;
            bf16x8 pf[2];
#pragma unroll
            for (int s2 = 0; s2 < 2; ++s2) { u32x4 w; w.x = cvtpk(s[8 * s2 + 0], s[8 * s2 + 1]); w.y = cvtpk(s[8 * s2 + 2], s[8 * s2 + 3]); w.z = cvtpk(s[8 * s2 + 4], s[8 * s2 + 5]); w.w = cvtpk(s[8 * s2 + 6], s[8 * s2 + 7]);
                pf[s2] = __builtin_bit_cast(bf16x8, w); }
#pragma unroll
            for (int s2 = 0; s2 < 2; ++s2) {
                const LAS unsigned short* tb = vs + (16 * s2 + 8 * hi + ((lane & 15) >> 2)) * 72 + 16 * ((lane >> 4) & 1) + 4 * (lane & 3);
                const s16x4 a0 = vtr(tb), a1 = vtr(tb + 4 * 72), b0_ = vtr(tb + 32), b1_ = vtr(tb + 4 * 72 + 32);
                const bf16x8 v0 = __builtin_shufflevector(a0, a1, 0, 1, 2, 3, 4, 5, 6, 7), v1 = __builtin_shufflevector(b0_, b1_, 0, 1, 2, 3, 4, 5, 6, 7);
                __builtin_amdgcn_s_setprio(1);
                o0 = __builtin_amdgcn_mfma_f32_32x32x16_bf16(v0, pf[s2], o0, 0, 0, 0);
                o1 = __builtin_amdgcn_mfma_f32_32x32x16_bf16(v1, pf[s2], o1, 0, 0, 0);
                __builtin_amdgcn_s_setprio(0);
            }
        }
        { auto rr = __builtin_amdgcn_permlane32_swap(__float_as_uint(l), __float_as_uint(l), false, false); l = __uint_as_float(rr[0]) + __uint_as_float(rr[1]); }
        const int slot = p.slot0 + p.sstride * r32, st = p.st;
        float ca, cb;
        if (st == 0) { ca = 1.0f / l; cb = 0.f; if (hi == 0) ML[slot] = (f32x2){m, l}; }
        else { const f32x2 ml = ML[slot]; const float M = fmaxf(m, ml.x), e1 = __builtin_amdgcn_exp2f(m - M), wn = l * e1, wo = ml.y * __builtin_amdgcn_exp2f(ml.x - M), inv = 1.0f / (wn + wo);
            ca = e1 * inv; cb = wo * inv; LDS_FENCE(); if (hi == 0) ML[slot] = (f32x2){M, wn + wo}; }
#pragma unroll
        for (int nh = 0; nh < 2; ++nh)
#pragma unroll
            for (int rg = 0; rg < 4; ++rg) {
                const int g4 = 8 * nh + 2 * rg + hi;
                LAS u32x2* pp = (LAS u32x2*)(lds + AT_PO + po_off(slot, g4));
                float v[4];
#pragma unroll
                for (int e2 = 0; e2 < 4; ++e2) v[e2] = ca * (nh ? o1[4 * rg + e2] : o0[4 * rg + e2]);
                if (st != 0) { const u32x2 old = *pp; v[0] += cb * bflo(old.x); v[1] += cb * bfhi(old.x); v[2] += cb * bflo(old.y); v[3] += cb * bfhi(old.y); }
                u32x2 w; w.x = cvtpk(v[0], v[1]); w.y = cvtpk(v[2], v[3]);
                if (st != 2) *pp = w;
                else *(u32x2*)(p.Oh + (size_t)slot * DM + 4 * g4) = w;
            }
        if (g & 1) asm volatile("s_waitcnt lgkmcnt(0)\n\ts_barrier" ::: "memory");
    }
#undef AT_LOADQ
#undef AT_LOAD
}

__device__ __forceinline__ void attn_sample_bh(LAS unsigned char* lds, int b, int h, const bf16* Q, const float* sk, const float* sv, const float* outp, bf16* MIX) {
    LAS float* qs = (LAS float*)lds;
    LAS float* sb = qs + 256;
    LAS float* lb = sb + 4 * 388;
    LAS float* red = lb + 16;
    const int tid = threadIdx.x, lane = tid & 63, wave = tid >> 6;
    if (tid < 256) qs[tid] = bf2f(Q[(size_t)(MP + b * 4 + (tid >> 6)) * DA + h * 64 + (tid & 63)]);
    __syncthreads();
    const float sl2 = __builtin_amdgcn_exp2f(-(float)(h + 1)) * LOG2E;
    {
        const int sub = tid & 3, grp = tid >> 2;
#pragma unroll 2
        for (int pi = grp; pi < 4 * 387; pi += 128) {
            const int i = pi / 387, rem = pi - i * 387, br = rem / 129, j = rem - br * 129, d = 1 << (2 * br), idx = 2048 + i - d * j;
            const float* kr = idx < 2048 ? sk + ((size_t)(b * 2048 + idx) * 8 + h) * 64 : outp + O_KS + (size_t)(b * 4 + idx - 2048) * DA + h * 64;
            float dot = 0.f;
#pragma unroll
            for (int c4 = 0; c4 < 4; ++c4) { const f32x4 kv = *(const f32x4*)(kr + 16 * c4 + 4 * sub); const LAS float* qq = qs + i * 64 + 16 * c4 + 4 * sub;
                dot += (kv.x * qq[0] + kv.y * qq[1]) + (kv.z * qq[2] + kv.w * qq[3]); }
            dot += __shfl_xor(dot, 1); dot += __shfl_xor(dot, 2);
            if (sub == 0) sb[i * 388 + rem] = dot - sl2 * (float)(d * j);
        }
    }
    __syncthreads();
    if (wave < 4) {
        float v[7], mx = -1e30f;
#pragma unroll
        for (int k = 0; k < 7; ++k) { const int idx = lane + 64 * k; v[k] = idx < 387 ? sb[wave * 388 + idx] : -1e30f; mx = fmaxf(mx, v[k]); }
        mx = wave_max(mx); float s = 0.f;
#pragma unroll
        for (int k = 0; k < 7; ++k) { const int idx = lane + 64 * k; const float p = __builtin_amdgcn_exp2f(v[k] - mx); if (idx < 387) { sb[wave * 388 + idx] = p; s += p; } }
        s = wave_sum(s); if (lane == 0) lb[wave] = s;
    }
    __syncthreads();
    { const int i = tid >> 7, kg = (tid & 127) >> 4, ch = tid & 15; f32x4 acc = {0.f, 0.f, 0.f, 0.f};
#pragma unroll 4
      for (int jj = kg; jj < 387; jj += 8) { const int br = jj / 129, j = jj - br * 129, d = 1 << (2 * br), idx = 2048 + i - d * j;
          const float* vr = idx < 2048 ? sv + ((size_t)(b * 2048 + idx) * 8 + h) * 64 : outp + O_VS + (size_t)(b * 4 + idx - 2048) * DA + h * 64;
          const f32x4 vv = *(const f32x4*)(vr + 4 * ch); acc += vv * sb[i * 388 + jj]; }
      *(LAS f32x4*)(red + (i * 8 + kg) * 64 + 4 * ch) = acc; }
    __syncthreads();
    if (tid < 256) { const int i = tid >> 6, dd = tid & 63; float s = 0.f;
#pragma unroll
        for (int kg = 0; kg < 8; ++kg) s += red[(i * 8 + kg) * 64 + dd];
        MIX[(size_t)(MP + b * 4 + i) * DM + h * 64 + dd] = (bf16)f2bf(s / lb[i]); }
    __syncthreads();
}

__device__ __forceinline__ void unpack8(const u32x4 w, float* f) { f[0] = bflo(w.x); f[1] = bfhi(w.x); f[2] = bflo(w.y); f[3] = bfhi(w.y); f[4] = bflo(w.z); f[5] = bfhi(w.z); f[6] = bflo(w.w); f[7] = bfhi(w.w); }
__device__ __forceinline__ void conv_rows(int vb, int G, const bf16* U, const bf16* Bg, const float* wconv, const float* sconv, bf16* MIX) {
    const int tid = threadIdx.x, rsub = tid >> 6, c8 = (tid & 63) * 8;
    float w0[8], w1[8], w2[8];
#pragma unroll
    for (int e = 0; e < 8; ++e) { w0[e] = wconv[c8 + e]; w1[e] = wconv[512 + c8 + e]; w2[e] = wconv[1024 + c8 + e]; }
    for (int r = vb * 8 + rsub; r < MV; r += G * 8) {
        float u2[8], u1[8], u0[8], gb[8];
        unpack8(*(const u32x4*)(U + (size_t)r * DA + c8), u2); unpack8(*(const u32x4*)(Bg + (size_t)r * DA + c8), gb);
        int i; const float* s1 = nullptr; const float* s0 = nullptr;
        if (r < MP) i = r & 2047;
        else { const int rr = r - MP; i = rr & 3; const float* sc = sconv + (size_t)(rr >> 2) * 1024 + c8; s1 = sc + 512; s0 = sc + (i == 0 ? 0 : 512); }
        if (i >= 1) unpack8(*(const u32x4*)(U + (size_t)(r - 1) * DA + c8), u1);
        else {
#pragma unroll
            for (int e = 0; e < 8; ++e) u1[e] = s1 ? s1[e] : 0.f; }
        if (i >= 2) unpack8(*(const u32x4*)(U + (size_t)(r - 2) * DA + c8), u0);
        else {
#pragma unroll
            for (int e = 0; e < 8; ++e) u0[e] = s0 ? s0[e] : 0.f; }
        float o[8];
#pragma unroll
        for (int e = 0; e < 8; ++e) o[e] = gb[e] * (w0[e] * u0[e] + w1[e] * u1[e] + w2[e] * u2[e]);
        u32x4 w; w.x = pk2(o[0], o[1]); w.y = pk2(o[2], o[3]); w.z = pk2(o[4], o[5]); w.w = pk2(o[6], o[7]);
        *(u32x4*)(MIX + (size_t)r * DM + 512 + c8) = w;
    }
}

template <int NKS  , class Epi>
__device__ __forceinline__ void thin_gemm(LAS unsigned char* lds, int vcu, int G, const bf16* A  , const bf16* Bt, int npn, const Epi& E) {
    constexpr int K = NKS * 128;
    const int tid = threadIdx.x, lane = tid & 63, wave = __builtin_amdgcn_readfirstlane(tid >> 6), r32 = lane & 31, hi = lane >> 5;
    LAS f32x4* red = (LAS f32x4*)lds;
    for (int t = vcu; t < npn * 16; t += G) {
        const int rb = t & 3, c32 = (t >> 2) & 3, pn = t >> 4;
        const bf16* ap = A + (size_t)(32 * rb + r32) * K + wave * (NKS * 16) + 8 * hi;
        const bf16* bp = Bt + (size_t)(256 * pn + 32 * c32 + r32) * K + wave * (NKS * 16) + 8 * hi;
        f32x16 a0, a1;
#pragma unroll
        for (int r = 0; r < 16; ++r) { a0[r] = 0.f; a1[r] = 0.f; }
        constexpr int CH = (NKS == 8) ? 8 : 11;
#pragma unroll
        for (int s0 = 0; s0 < NKS; s0 += CH) {
            bf16x8 af[CH], b0[CH], b1[CH];
#pragma unroll
            for (int s = 0; s < CH; ++s) { af[s] = *(const bf16x8*)(ap + 16 * (s0 + s)); b0[s] = *(const bf16x8*)(bp + 16 * (s0 + s)); b1[s] = *(const bf16x8*)(bp + (size_t)128 * K + 16 * (s0 + s)); }
            __builtin_amdgcn_sched_barrier(0);
#pragma unroll
            for (int s = 0; s < CH; ++s) {
                a0 = __builtin_amdgcn_mfma_f32_32x32x16_bf16(b0[s], af[s], a0, 0, 0, 0);
                a1 = __builtin_amdgcn_mfma_f32_32x32x16_bf16(b1[s], af[s], a1, 0, 0, 0);
            }
            __builtin_amdgcn_sched_barrier(0);
        }
#pragma unroll
        for (int rg = 0; rg < 4; ++rg) {
            red[((wave * 2 + 0) * 4 + rg) * 64 + lane] = (f32x4){a0[4 * rg], a0[4 * rg + 1], a0[4 * rg + 2], a0[4 * rg + 3]};
            red[((wave * 2 + 1) * 4 + rg) * 64 + lane] = (f32x4){a1[4 * rg], a1[4 * rg + 1], a1[4 * rg + 2], a1[4 * rg + 3]};
        }
        __syncthreads();
        if (tid < 256) {
            const int rg = tid >> 6; f32x4 v0 = {0.f, 0.f, 0.f, 0.f}, v1 = {0.f, 0.f, 0.f, 0.f};
#pragma unroll
            for (int w = 0; w < 8; ++w) { v0 += red[((w * 2 + 0) * 4 + rg) * 64 + lane]; v1 += red[((w * 2 + 1) * 4 + rg) * 64 + lane]; }
            E.thin(MP + 32 * rb + r32, pn, 32 * c32 + 8 * rg + 4 * hi, v0, v1);
        }
        __syncthreads();
    }
}

struct Args { const float* in[14]; float* out; unsigned char* ws; };
__global__ void __launch_bounds__(512, 2) fwd_kernel(Args a) {
    extern __shared__ __attribute__((aligned(16))) unsigned char lds_raw[];
    LAS unsigned char* lds = (LAS unsigned char*)lds_raw;
    cg::grid_group grid = cg::this_grid();
    const int tid = threadIdx.x, lane = tid & 63, wave = __builtin_amdgcn_readfirstlane(tid >> 6);
    const int G = gridDim.x, bx = blockIdx.x;
    const int vcu = (G % 8 == 0) ? (bx % 8) * (G / 8) + bx / 8 : bx;
    unsigned char* ws = a.ws;
    const float* x_p = a.in[0]; const float* x_s = a.in[1]; const float* st_k = a.in[2]; const float* st_v = a.in[3]; const float* st_c = a.in[4];
    const float* g_mix = a.in[5]; const float* w_in = a.in[6]; const float* w_conv = a.in[7]; const float* w_out = a.in[8]; const float* g_ffn = a.in[9];
    const float* w_gate = a.in[10]; const float* w_up = a.in[11]; const float* w_down = a.in[12]; const float* g_fin = a.in[13];
    float* out = a.out;
    unsigned long long* ss1 = (unsigned long long*)(ws + WS_SS1); unsigned long long* ss2 = (unsigned long long*)(ws + WS_SS2);
    bf16* Win = (bf16*)(ws + WS_WIN); bf16* Wout = (bf16*)(ws + WS_WOUT); bf16* Wgu = (bf16*)(ws + WS_WGU); bf16* Wdn = (bf16*)(ws + WS_WDN);
    bf16* XN = (bf16*)(ws + WS_XN); bf16* Qb = (bf16*)(ws + WS_Q); bf16* Kb = (bf16*)(ws + WS_K); bf16* Vb = (bf16*)(ws + WS_V);
    bf16* Ub = (bf16*)(ws + WS_U); bf16* Bb = (bf16*)(ws + WS_B); bf16* MIX = (bf16*)(ws + WS_MIX); bf16* ACT = (bf16*)(ws + WS_ACT);

    volatile LAS unsigned* MISC = (volatile LAS unsigned*)(lds + LDS_BYTES - 128);
    if (tid < 32) MISC[tid] = 0u;
    __syncthreads();
    {
        LAS float* scr = (LAS float*)(lds + wave * 16384);
        const int gw = vcu * 8 + wave, NGW = G * 8;
        constexpr int I_IN = 16 * 96, I_OUT = 16 * 32, I_GU = 16 * 176, I_DN = 44 * 32, NITEMS = I_IN + I_OUT + I_GU + I_DN;
        for (int it = gw; it < NITEMS; it += NGW) {
            int r = it;
            if (r < I_IN) { const int kb = r / 96, db = r % 96, rho = 32 * db; int sc;
                if (rho < 1536) sc = rho;
                else if (rho < 2560) { const int j = (rho - 1536) >> 8, w = (rho - 1536) & 255; sc = w < 128 ? 1536 + 128 * j + w : 2560 + 128 * j + (w - 128); }
                else sc = 2048 + (rho - 2560);
                transpose_item(w_in, DIN, DM, Win, rho, sc, kb, scr, lane); continue; }
            r -= I_IN;
            if (r < I_OUT) { const int kb = r / 32, db = r % 32; transpose_item(w_out, DM, DM, Wout, 32 * db, 32 * db, kb, scr, lane); continue; }
            r -= I_OUT;
            if (r < I_GU) { const int kb = r / 176, db = r % 176, rho = 32 * db, pn = rho >> 8, w = rho & 255;
                transpose_item(w < 128 ? w_gate : w_up, DFF, DM, Wgu, rho, 128 * pn + (w & 127), kb, scr, lane); continue; }
            r -= I_GU;
            { const int kb = r / 32, db = r % 32; transpose_item(w_down, DM, DFF, Wdn, 32 * db, 32 * db, kb, scr, lane); }
        }
        for (int m = gw; m < MT; m += 2 * NGW) {
            const int m1 = m + NGW;
            const float* x0 = m < MV ? (m < MP ? x_p + (size_t)m * DM : x_s + (size_t)(m - MP) * DM) : nullptr;
            const float* x1 = m1 < MV ? (m1 < MP ? x_p + (size_t)m1 * DM : x_s + (size_t)(m1 - MP) * DM) : nullptr;
            if (x0) rms_rows2_to_bf16(x0, x1, g_mix, XN + (size_t)m * DM, XN + (size_t)m1 * DM, lane);
        }
    }
    { unsigned long long* ctl = (unsigned long long*)ws; for (int i = bx * 512 + tid; i < (int)(WS_CTL_BYTES / 8); i += G * 512) ctl[i] = 0ull; }
    __syncthreads();
    grid.sync();
    XcdBarrier bar = xcd_barrier_post((unsigned*)(ws + WS_BAR), MISC + 8);

    {
        pg8::Gemm g{XN, Win, MP, DIN, DM}; pg8::StaticOrder S; S.init(MP, DIN, G, bx);
        pg8::EpiIn E{Qb, Kb, Vb, Ub, Bb, out};
        thin_gemm<8>(lds, vcu, G, XN + (size_t)MP * DM, Win, DIN / 256, E);
        pg8::gemm_phase<pg8::EpiIn, pg8::StaticOrder, true, true>(lds, g, S, E);
    }
    xcd_barrier(bar);

    {
        if (vcu & 1) { for (int bh = vcu; bh < 256; bh += G) attn_sample_bh(lds, bh >> 3, bh & 7, Qb, st_k, st_v, out, MIX); }
        attn_prompt_all(lds, vcu, G, Qb, Kb, Vb, MIX);
        if (!(vcu & 1)) { for (int bh = vcu; bh < 256; bh += G) attn_sample_bh(lds, bh >> 3, bh & 7, Qb, st_k, st_v, out, MIX); }
        conv_rows(vcu, G, Ub, Bb, w_conv, st_c, MIX);
    }
    xcd_barrier(bar);

    {
        pg8::Gemm g{MIX, Wout, MP, DM, DM}; pg8::StaticOrder S; S.init(MP, DM, G, bx);
        pg8::EpiOut E{x_p, x_s, out, XN, g_ffn, ss1};
        thin_gemm<8>(lds, vcu, G, MIX + (size_t)MP * DM, Wout, DM / 256, E);
        pg8::gemm_phase<pg8::EpiOut, pg8::StaticOrder, true, true>(lds, g, S, E);
    }
    xcd_barrier(bar);

    {
        pg8::Gemm g{XN, Wgu, MP, 2 * DFF, DM}; pg8::StaticOrder S; S.init(MP, 2 * DFF, G, bx);
        pg8::EpiGU E{ACT, ss1};
        thin_gemm<8>(lds, vcu, G, XN + (size_t)MP * DM, Wgu, 2 * DFF / 256, E);
        pg8::gemm_phase<pg8::EpiGU, pg8::StaticOrder, true, true>(lds, g, S, E);
    }
    xcd_barrier(bar);

    {
        pg8::Gemm g{ACT, Wdn, MP, DM, DFF}; pg8::StaticOrder S; S.init(MP, DM, G, bx);
        pg8::EpiDown E{out, ss2, XN, g_ffn, g_fin};
        thin_gemm<22>(lds, vcu, G, ACT + (size_t)MP * DFF, Wdn, DM / 256, E);
        pg8::gemm_phase<pg8::EpiDown, pg8::StaticOrder, true, true>(lds, g, S, E);
    }
}

extern "C" void kernel_launch(void* const* d_in, const int* in_sizes, int n_in, void* d_out, int out_size, void* d_ws, size_t ws_size, hipStream_t stream) {
    static int grid = 0;
    if (grid == 0) {
        if (n_in != 14 || (size_t)out_size != O_END || ws_size < WS_END) { fprintf(stderr, "kernel_launch: unexpected shapes (n_in %d, out %d, ws %zu)\n", n_in, out_size, ws_size); grid = -1; return; }
        int dev = 0, cus = 0, per_cu = 0;
        hipGetDevice(&dev); hipDeviceGetAttribute(&cus, hipDeviceAttributeMultiprocessorCount, dev);
        if (hipFuncSetAttribute((const void*)fwd_kernel, hipFuncAttributeMaxDynamicSharedMemorySize, LDS_BYTES) != hipSuccess) { fprintf(stderr, "kernel_launch: hipFuncSetAttribute failed\n"); grid = -1; return; }
        if (hipOccupancyMaxActiveBlocksPerMultiprocessor(&per_cu, (const void*)fwd_kernel, 512, LDS_BYTES) != hipSuccess || per_cu < 1) { fprintf(stderr, "kernel_launch: occupancy query gave %d\n", per_cu); per_cu = 1; }
        (void)hipGetLastError();
        grid = cus * 1;
        if (grid <= 0) grid = 256;
    }
    if (grid < 0) return;
    Args a{};
    for (int i = 0; i < 14; ++i) a.in[i] = (const float*)d_in[i];
    a.out = (float*)d_out; a.ws = (unsigned char*)d_ws;
    void* args[] = {&a};
    hipError_t e = hipLaunchCooperativeKernel((const void*)fwd_kernel, dim3(grid), dim3(512), args, LDS_BYTES, stream);
    if (e != hipSuccess) fprintf(stderr, "cooperative launch failed: %s (grid %d)\n", hipGetErrorString(e), grid);
}
```

```cpp
#include <hip/hip_runtime.h>
#include <hip/hip_cooperative_groups.h>
#include <cstdio>
#include <cstdint>
namespace cg = cooperative_groups;

constexpr int MP = 32768;
constexpr int MSR = 128;
constexpr int MV = MP + MSR;
constexpr int MT = MP + 256;
constexpr int DM = 1024, DA = 512, DIN = 3072, DFF = 2816;
constexpr float RMS_EPS = 1e-6f;
constexpr float LOG2E = 1.4426950408889634f;
constexpr float QSCALE = 0.125f * LOG2E;
constexpr size_t O_Y = 0;
constexpr size_t O_KP = (size_t)MV * DM;
constexpr size_t O_VP = O_KP + (size_t)MP * DA;
constexpr size_t O_CP = O_VP + (size_t)MP * DA;
constexpr size_t O_KS = O_CP + 16 * 2 * 512;
constexpr size_t O_VS = O_KS + (size_t)MSR * DA;
constexpr size_t O_CS = O_VS + (size_t)MSR * DA;
constexpr size_t O_END = O_CS + 32 * 2 * 512;
namespace pg8 {
#define PG8_LAS __attribute__((address_space(3)))
typedef unsigned short bf16_t;
typedef short bf16x8 __attribute__((ext_vector_type(8)));
typedef float f32x4 __attribute__((ext_vector_type(4)));
typedef unsigned u32x4 __attribute__((ext_vector_type(4)));
constexpr int BM = 256, BK = 64, HALF = 128, HTB = HALF * BK * 2  , STAGE_BYTES = 8 * HTB, NXCD = 8, WGM = 8;

__host__ __device__ __forceinline__ int lds_byte(int r, int c) { const int st = (r >> 4) * 2 + (c >> 5), rr = r & 15, cc = c & 31, ob = rr * 64 + cc * 2; return st * 1024 + (ob ^ (((ob >> 9) & 1) << 5)); }
__host__ __device__ __forceinline__ void stage_rc(int b, int& R, int& C) { const int st = b / 1024, sb = b % 1024, swz = sb ^ (((sb >> 9) & 1) << 5); R = (st >> 1) * 16 + swz / 64; C = (st & 1) * 32 + (swz % 64) / 2; }
__host__ __device__ __forceinline__ int perm32(int rho) { const int n = rho >> 4, i = rho & 15; return 8 * (i >> 2) + 4 * n + (i & 3); }

struct Unit { int pm, pn; };
struct Gemm { const bf16_t* A; const bf16_t* Bt; int M, N, K; };

struct StaticOrder {
    int nM, nN, nwg, G, c;
    __host__ __device__ void init(int M, int N, int G_, int c_) { nM = M / BM; nN = N / BM; nwg = nM * nN; G = G_; c = c_; }
    __host__ __device__ bool next(int i, Unit& u) const {
        const long L = (long)i * G + c; if (L >= nwg) return false;
        int wgid = (int)L; { const int q = nwg / NXCD, r = nwg % NXCD, xcd = wgid % NXCD, off = wgid / NXCD; wgid = (xcd < r ? xcd * (q + 1) : r * (q + 1) + (xcd - r) * q) + off; }
        const int nig = WGM * nN, gid = wgid / nig, fm = gid * WGM, gsz = (nM - fm) < WGM ? (nM - fm) : WGM;
        u.pm = fm + ((wgid % nig) % gsz); u.pn = (wgid % nig) / gsz; return true;
    }
    __device__ __forceinline__ void a_ready(const Unit&) const {}
    __device__ __forceinline__ void done(const Unit&) const {}
};

__device__ __forceinline__ unsigned cvt_pk_bf16(float lo, float hi) { unsigned r; asm volatile("v_cvt_pk_bf16_f32 %0, %1, %2" : "=v"(r) : "v"(lo), "v"(hi)); return r; }
typedef __bf16 bf16x2v __attribute__((ext_vector_type(2))); typedef float f32x2v __attribute__((ext_vector_type(2)));
__device__ __forceinline__ unsigned cvt2(float lo, float hi) { f32x2v v = {lo, hi}; bf16x2v b = __builtin_convertvector(v, bf16x2v); return __builtin_bit_cast(unsigned, b); }
__device__ __forceinline__ u32x4 pack8(const f32x4 a, const f32x4 b) { u32x4 w; w.x = cvt2(a[0], a[1]); w.y = cvt2(a[2], a[3]); w.z = cvt2(b[0], b[1]); w.w = cvt2(b[2], b[3]); return w; }
typedef unsigned u32x2 __attribute__((ext_vector_type(2)));
__device__ __forceinline__ u32x2 pack4(const f32x4 a) { u32x2 w; w.x = cvt2(a[0], a[1]); w.y = cvt2(a[2], a[3]); return w; }
__device__ __forceinline__ void st_nt(float* p, const f32x4 v) { __builtin_nontemporal_store(v, (f32x4*)p); }
__device__ __forceinline__ f32x4 ld_nt(const float* p) { return __builtin_nontemporal_load((const f32x4*)p); }
__device__ __forceinline__ float dot4(const f32x4 a) { return (a[0] * a[0] + a[1] * a[1]) + (a[2] * a[2] + a[3] * a[3]); }

struct EpiIn {
    static constexpr bool PERM = true, AFTER_DRAIN = false, PREFETCH = false; struct Pre {};
    bf16_t *Q, *K, *V, *U, *B; float* out;
    __device__ __forceinline__ void operator()(const f32x4 (&acc)[2][2][4][2], const Unit& u, int wr, int wc, int fr, int fq) const {
        const int row0 = u.pm * BM + wr * 64 + fr, pn = u.pn, cw = wc * 32 + 8 * fq;
#pragma unroll
        for (int ai = 0; ai < 2; ++ai)
#pragma unroll
            for (int m = 0; m < 4; ++m) {
                const int row = row0 + ai * HALF + m * 16;
                if (row >= MV) continue;
                if (pn < 2) {
#pragma unroll
                    for (int bj = 0; bj < 2; ++bj) { const int col = pn * 256 + bj * HALF + cw;
                        *(u32x4*)(Q + (size_t)row * DA + col) = pack8(acc[ai][bj][m][0] * QSCALE, acc[ai][bj][m][1] * QSCALE); }
                } else if (pn < 6) {
                    const bool isk = pn < 4; bf16_t* W = isk ? K : V;
                    float* op = out + (row < MP ? (isk ? O_KP : O_VP) + (size_t)row * DA : (isk ? O_KS : O_VS) + (size_t)(row - MP) * DA);
#pragma unroll
                    for (int bj = 0; bj < 2; ++bj) { const int col = (pn & 1) * 256 + bj * HALF + cw;
                        *(u32x4*)(W + (size_t)row * DA + col) = pack8(acc[ai][bj][m][0], acc[ai][bj][m][1]);
                        st_nt(op + col, acc[ai][bj][m][0]); st_nt(op + col + 4, acc[ai][bj][m][1]); }
                } else if (pn < 10) {
                    const int col = (pn - 6) * HALF + cw;
                    const f32x4 u0 = acc[ai][0][m][0] * acc[ai][1][m][0], u1 = acc[ai][0][m][1] * acc[ai][1][m][1];
                    *(u32x4*)(U + (size_t)row * DA + col) = pack8(u0, u1);
                    if (row < MP) { const int t = row & 2047; if (t >= 2046) { float* op = out + O_CP + (size_t)((row >> 11) * 2 + (t - 2046)) * 512 + col; *(f32x4*)op = u0; *(f32x4*)(op + 4) = u1; } }
                    else { const int rr = row - MP, i = rr & 3; if (i >= 2) { float* op = out + O_CS + (size_t)((rr >> 2) * 2 + (i - 2)) * 512 + col; *(f32x4*)op = u0; *(f32x4*)(op + 4) = u1; } }
                } else {
#pragma unroll
                    for (int bj = 0; bj < 2; ++bj) { const int col = (pn - 10) * 256 + bj * HALF + cw;
                        *(u32x4*)(B + (size_t)row * DA + col) = pack8(acc[ai][bj][m][0], acc[ai][bj][m][1]); }
                }
            }
    }
    __device__ __forceinline__ void thin(int row, int pn, int cw, const f32x4 v0, const f32x4 v1) const {
        if (pn < 2) { bf16_t* p = Q + (size_t)row * DA + pn * 256 + cw; *(u32x2*)p = pack4(v0 * QSCALE); *(u32x2*)(p + HALF) = pack4(v1 * QSCALE); }
        else if (pn < 6) { const bool isk = pn < 4; bf16_t* p = (isk ? K : V) + (size_t)row * DA + (pn & 1) * 256 + cw; *(u32x2*)p = pack4(v0); *(u32x2*)(p + HALF) = pack4(v1);
            float* op = out + (isk ? O_KS : O_VS) + (size_t)(row - MP) * DA + (pn & 1) * 256 + cw; *(f32x4*)op = v0; *(f32x4*)(op + HALF) = v1; }
        else if (pn < 10) { const int col = (pn - 6) * HALF + cw; const f32x4 uu = v0 * v1; *(u32x2*)(U + (size_t)row * DA + col) = pack4(uu);
            const int rr = row - MP, i = rr & 3; if (i >= 2) *(f32x4*)(out + O_CS + (size_t)((rr >> 2) * 2 + (i - 2)) * 512 + col) = uu; }
        else { bf16_t* p = B + (size_t)row * DA + (pn - 10) * 256 + cw; *(u32x2*)p = pack4(v0); *(u32x2*)(p + HALF) = pack4(v1); }
    }
};

#define PG8_RLX_AGENT2 __ATOMIC_RELAXED, __HIP_MEMORY_SCOPE_AGENT
__device__ __forceinline__ unsigned long long ssq_word(float sq) { return ((unsigned long long)(sq * 4294967296.0f) << 8) | 1ull; }
__device__ __forceinline__ float ssq_value(unsigned long long w) { return (float)(w >> 8) * (1.0f / 4294967296.0f); }
struct EpiOut {
    static constexpr bool PERM = true, AFTER_DRAIN = false, PREFETCH = false; struct Pre {};
    const float* xp; const float* xs; float* out; bf16_t* HG; const float* g; unsigned long long* ss;
    __device__ __forceinline__ void operator()(const f32x4 (&acc)[2][2][4][2], const Unit& u, int wr, int wc, int fr, int fq) const {
        const int row0 = u.pm * BM + wr * 64 + fr, colb = u.pn * 256 + wc * 32 + 8 * fq;
        f32x4 gv[2][2];
#pragma unroll
        for (int bj = 0; bj < 2; ++bj)
#pragma unroll
            for (int n = 0; n < 2; ++n) gv[bj][n] = *(const f32x4*)(g + colb + bj * HALF + 4 * n);
#pragma unroll
        for (int ai = 0; ai < 2; ++ai)
#pragma unroll
            for (int m = 0; m < 4; ++m) {
                const int row = row0 + ai * HALF + m * 16; const bool ok = row < MV;
                float sq = 0.f;
                if (ok) {
                    const float* xr = row < MP ? xp + (size_t)row * DM : xs + (size_t)(row - MP) * DM;
                    bf16_t* hrow = HG + (size_t)row * DM;
#pragma unroll
                    for (int bj = 0; bj < 2; ++bj) { const int col = colb + bj * HALF;
                        const f32x4 h0 = ld_nt(xr + col) + acc[ai][bj][m][0], h1 = ld_nt(xr + col + 4) + acc[ai][bj][m][1];
                        sq += dot4(h0) + dot4(h1);
                        *(u32x4*)(hrow + col) = pack8(h0 * gv[bj][0], h1 * gv[bj][1]); }
                }
                sq += __shfl_xor(sq, 16); sq += __shfl_xor(sq, 32);
                if (ok && fq == 0) (void)__hip_atomic_fetch_add(ss + row, ssq_word(sq), PG8_RLX_AGENT2);
            }
    }
    __device__ __forceinline__ void thin(int row, int pn, int cw, const f32x4 v0, const f32x4 v1) const {
        const int col = pn * 256 + cw; const float* xr = xs + (size_t)(row - MP) * DM + col; bf16_t* hrow = HG + (size_t)row * DM + col;
        const f32x4 h0 = *(const f32x4*)xr + v0, h1 = *(const f32x4*)(xr + HALF) + v1;
        *(u32x2*)hrow = pack4(h0 * *(const f32x4*)(g + col)); *(u32x2*)(hrow + HALF) = pack4(h1 * *(const f32x4*)(g + col + HALF));
        (void)__hip_atomic_fetch_add(ss + row, ssq_word(dot4(h0) + dot4(h1)), PG8_RLX_AGENT2);
    }
};

struct EpiGU {
    static constexpr bool PERM = true, AFTER_DRAIN = false, PREFETCH = true;
    struct Pre { unsigned hi[2][4]; };
    bf16_t* ACT; const unsigned long long* ss;
    __device__ __forceinline__ void prefetch(Pre& p, const Unit& u, int wr, int fr) const {
        const unsigned* w = (const unsigned*)(ss + u.pm * BM + wr * 64 + fr) + 1;
#pragma unroll
        for (int ai = 0; ai < 2; ++ai)
#pragma unroll
            for (int m = 0; m < 4; ++m) p.hi[ai][m] = w[2 * (ai * HALF + m * 16)];
    }
    __device__ __forceinline__ void operator()(const f32x4 (&acc)[2][2][4][2], const Unit& u, int wr, int wc, int fr, int fq, const Pre& p) const {
        const int row0 = u.pm * BM + wr * 64 + fr, col = u.pn * HALF + wc * 32 + 8 * fq;
#pragma unroll
        for (int ai = 0; ai < 2; ++ai)
#pragma unroll
            for (int m = 0; m < 4; ++m) {
                const int row = row0 + ai * HALF + m * 16;
                const float rs = __builtin_amdgcn_rsqf((float)p.hi[ai][m] * (1.0f / (256.0f * DM)) + RMS_EPS), rs2 = rs * rs, ce = -rs * LOG2E;
                f32x4 o[2];
#pragma unroll
                for (int n = 0; n < 2; ++n) {
                    const f32x4 gu = acc[ai][0][m][n] * acc[ai][1][m][n] * rs2, ex = acc[ai][0][m][n] * ce;
                    f32x4 ev, rv;
#pragma unroll
                    for (int e = 0; e < 4; ++e) ev[e] = __builtin_amdgcn_exp2f(ex[e]);
                    const f32x4 den = ev + 1.0f;
#pragma unroll
                    for (int e = 0; e < 4; ++e) rv[e] = __builtin_amdgcn_rcpf(den[e]);
                    o[n] = gu * rv; }
                *(u32x4*)(ACT + (size_t)row * DFF + col) = pack8(o[0], o[1]);
            }
    }
    __device__ __forceinline__ void thin(int row, int pn, int cw, const f32x4 v0, const f32x4 v1) const {
        const float rs = 1.0f / sqrtf(ssq_value(ss[row]) * (1.0f / DM) + RMS_EPS); f32x4 o;
#pragma unroll
        for (int e = 0; e < 4; ++e) { const float gt = v0[e] * rs, up = v1[e] * rs; o[e] = gt * __builtin_amdgcn_rcpf(1.0f + __builtin_amdgcn_exp2f(-gt * LOG2E)) * up; }
        *(u32x2*)(ACT + (size_t)row * DFF + pn * HALF + cw) = pack4(o);
    }
};

__device__ __forceinline__ f32x4 bf4_to_f32(const u32x2 w) { f32x4 r; r[0] = __builtin_bit_cast(float, w.x << 16); r[1] = __builtin_bit_cast(float, w.x & 0xffff0000u); r[2] = __builtin_bit_cast(float, w.y << 16); r[3] = __builtin_bit_cast(float, w.y & 0xffff0000u); return r; }
#define PG8_RLX_AGENT __ATOMIC_RELAXED, __HIP_MEMORY_SCOPE_AGENT
struct EpiDown {
    static constexpr bool PERM = true, AFTER_DRAIN = false, PREFETCH = false; struct Pre {};
    float* out; unsigned long long* ss; const bf16_t* HG; const float* g; const float* gfin;
    __device__ __forceinline__ void operator()(f32x4 (&acc)[2][2][4][2], const Unit& u, int wr, int wc, int fr, int fq) const {
        const int row0 = u.pm * BM + wr * 64 + fr, colb = u.pn * 256 + wc * 32 + 8 * fq;
        {
            f32x4 gi[2][2];
#pragma unroll
            for (int bj = 0; bj < 2; ++bj)
#pragma unroll
                for (int n = 0; n < 2; ++n) { const f32x4 gg = *(const f32x4*)(g + colb + bj * HALF + 4 * n);
#pragma unroll
                    for (int e = 0; e < 4; ++e) gi[bj][n][e] = __builtin_amdgcn_rcpf(gg[e]); }
#pragma unroll
            for (int ai = 0; ai < 2; ++ai)
#pragma unroll
                for (int m = 0; m < 4; ++m) {
                    const int row = row0 + ai * HALF + m * 16; const bf16_t* hrow = HG + (size_t)row * DM;
                    float sq = 0.f;
#pragma unroll
                    for (int bj = 0; bj < 2; ++bj) { const int col = colb + bj * HALF; const u32x4 hw = *(const u32x4*)(hrow + col);
                        const f32x4 h0 = bf4_to_f32((u32x2){hw.x, hw.y}) * gi[bj][0] + acc[ai][bj][m][0], h1 = bf4_to_f32((u32x2){hw.z, hw.w}) * gi[bj][1] + acc[ai][bj][m][1];
                        acc[ai][bj][m][0] = h0; acc[ai][bj][m][1] = h1; sq += dot4(h0) + dot4(h1); }
                    sq += __shfl_xor(sq, 16); sq += __shfl_xor(sq, 32);
                    if (fq == 0) (void)__hip_atomic_fetch_add(ss + row, ssq_word(sq), PG8_RLX_AGENT);
                }
        }
        f32x4 gf[2][2];
#pragma unroll
        for (int bj = 0; bj < 2; ++bj)
#pragma unroll
            for (int n = 0; n < 2; ++n) gf[bj][n] = *(const f32x4*)(gfin + colb + bj * HALF + 4 * n);
        unsigned long long tw[2][4];
        for (unsigned sp = 0u;; ++sp) {
            bool done = true;
#pragma unroll
            for (int ai = 0; ai < 2; ++ai)
#pragma unroll
                for (int m = 0; m < 4; ++m) { tw[ai][m] = __hip_atomic_load(ss + row0 + ai * HALF + m * 16, PG8_RLX_AGENT); done = done && ((unsigned)tw[ai][m] & 255u) >= 16u; }
            if (!__any(!done) || sp > (1u << 20)) break;
            __builtin_amdgcn_s_sleep(2);
        }
#pragma unroll
        for (int ai = 0; ai < 2; ++ai)
#pragma unroll
            for (int m = 0; m < 4; ++m) {
                const int row = row0 + ai * HALF + m * 16; float* orow = out + (size_t)row * DM;
                const float rs = 1.0f / sqrtf(ssq_value(tw[ai][m]) * (1.0f / DM) + RMS_EPS);
#pragma unroll
                for (int bj = 0; bj < 2; ++bj) { const int col = colb + bj * HALF;
                    st_nt(orow + col, acc[ai][bj][m][0] * rs * gf[bj][0]); st_nt(orow + col + 4, acc[ai][bj][m][1] * rs * gf[bj][1]); }
            }
    }
    __device__ __forceinline__ void thin(int row, int pn, int cw, const f32x4 v0, const f32x4 v1) const {
        const int col = pn * 256 + cw; float* orow = out + (size_t)row * DM + col; const bf16_t* hrow = HG + (size_t)row * DM + col;
        const f32x4 g0 = *(const f32x4*)(g + col), g1 = *(const f32x4*)(g + col + HALF);
        const f32x4 h0 = bf4_to_f32(*(const u32x2*)hrow) / g0 + v0, h1 = bf4_to_f32(*(const u32x2*)(hrow + HALF)) / g1 + v1;
        (void)__hip_atomic_fetch_add(ss + row, ssq_word(dot4(h0) + dot4(h1)), PG8_RLX_AGENT);
        const f32x4 f0 = *(const f32x4*)(gfin + col), f1 = *(const f32x4*)(gfin + col + HALF);
        unsigned long long w;
        for (unsigned sp = 0u;; ++sp) { w = __hip_atomic_load(ss + row, PG8_RLX_AGENT); if (!__any(((unsigned)w & 255u) < 128u) || sp > (1u << 20)) break; __builtin_amdgcn_s_sleep(2); }
        const float rs = 1.0f / sqrtf(ssq_value(w) * (1.0f / DM) + RMS_EPS);
        *(f32x4*)orow = h0 * rs * f0; *(f32x4*)(orow + HALF) = h1 * rs * f1;
    }
};
template <class Epi, class Sched, bool ALIGN_EPI = false, bool SP2 = false>
__device__ __forceinline__ void gemm_phase(PG8_LAS unsigned char* lds, const Gemm g, const Sched& S, const Epi& E) {
    int tid_ = threadIdx.x; asm volatile("" : "+v"(tid_));
    const int tid = tid_, wid = __builtin_amdgcn_readfirstlane(tid >> 6), lane = tid & 63, wr = wid >> 2, wc = wid & 3, fr = lane & 15, fq = lane >> 4;
    const int K = g.K, nt = K / BK;
    unsigned voffA[2], voffB[2];
#pragma unroll
    for (int i = 0; i < 2; ++i) { int R, C; stage_rc(tid * 16 + i * 8192, R, C); const int Rb = Epi::PERM ? ((R & ~31) + perm32(R & 31)) : R;
        voffA[i] = (unsigned)(R * K + C) * 2u; voffB[i] = (unsigned)(Rb * K + C) * 2u; }
    const size_t kstep = (size_t)(BK * 2);
    const size_t hstep = (size_t)HALF * K * 2;
    const size_t tstep = 2 * hstep;
    const unsigned ldsw = (unsigned)wid * 1024u;
    const int aoff = lds_byte(wr * 64 + fr, fq * 8), boff = lds_byte(wc * 32 + fr, fq * 8);
#define PG8_SA(b, h) (((b) * 2 + (h)) * HTB)
#define PG8_SB(b, h) ((4 + (b) * 2 + (h)) * HTB)
#define PG8_STAGE(bufoff, gbase, voff) do { _Pragma("unroll") for (int _i = 0; _i < 2; ++_i) \
        __builtin_amdgcn_global_load_lds((const unsigned*)((const char*)(gbase) + (voff)[_i]), (PG8_LAS unsigned*)(lds + (bufoff) + ldsw + _i * 8192), 16, 0, 0); } while (0)
#define PG8_LDA(dst, b, h) do { _Pragma("unroll") for (int m = 0; m < 4; ++m) _Pragma("unroll") for (int k = 0; k < 2; ++k) dst[m][k] = *(const PG8_LAS bf16x8*)(lds + PG8_SA(b, h) + aoff + m * 2048 + k * 1024); } while (0)
#define PG8_LDB(dst, b, h) do { _Pragma("unroll") for (int n = 0; n < 2; ++n) _Pragma("unroll") for (int k = 0; k < 2; ++k) dst[n][k] = *(const PG8_LAS bf16x8*)(lds + PG8_SB(b, h) + boff + n * 2048 + k * 1024); } while (0)
#define PG8_MMA(ai, bj, At, Bt) do { __builtin_amdgcn_s_setprio(1); _Pragma("unroll") for (int m = 0; m < 4; ++m) _Pragma("unroll") for (int n = 0; n < 2; ++n) _Pragma("unroll") for (int k = 0; k < 2; ++k) \
        acc[ai][bj][m][n] = __builtin_amdgcn_mfma_f32_16x16x32_bf16(Bt[n][k], At[m][k], acc[ai][bj][m][n], 0, 0, 0); __builtin_amdgcn_s_setprio(0); } while (0)
#define PG8_WAIT_V(n) asm volatile("s_waitcnt vmcnt(" #n ")" ::: "memory")
#define PG8_WAIT_L(n) asm volatile("s_waitcnt lgkmcnt(" #n ")" ::: "memory")
#define PG8_BAR __builtin_amdgcn_s_barrier()
#define PG8_SCHED __builtin_amdgcn_sched_barrier(0)
    Unit cur, nxt; int ui = 0;
    if (!S.next(0, cur)) return;
    f32x4 acc[2][2][4][2];
    typename Epi::Pre pre_{};
#pragma unroll
    for (int a = 0; a < 2; ++a)
#pragma unroll
        for (int b = 0; b < 2; ++b)
#pragma unroll
            for (int m = 0; m < 4; ++m)
#pragma unroll
                for (int n = 0; n < 2; ++n) acc[a][b][m][n] = (f32x4){0.f, 0.f, 0.f, 0.f};
    bf16x8 At[4][2], B0[2][2], B1[2][2];
    const char* cA = (const char*)g.A + (size_t)cur.pm * tstep; const char* cB = (const char*)g.Bt + (size_t)cur.pn * tstep;
    S.a_ready(cur);
    if constexpr (SP2) {
        PG8_STAGE(PG8_SB(0, 0), cB, voffB); PG8_STAGE(PG8_SB(0, 1), cB + hstep, voffB); PG8_STAGE(PG8_SA(0, 0), cA, voffA); PG8_STAGE(PG8_SA(0, 1), cA + hstep, voffA);
        if (wr == 1) PG8_BAR;
        PG8_WAIT_V(2); PG8_BAR;
        PG8_STAGE(PG8_SB(1, 0), cB + kstep, voffB); PG8_STAGE(PG8_SA(1, 0), cA + kstep, voffA); PG8_STAGE(PG8_SB(1, 1), cB + hstep + kstep, voffB);
        PG8_WAIT_V(6); PG8_BAR;
    } else {
        PG8_STAGE(PG8_SB(0, 0), cB, voffB); PG8_STAGE(PG8_SA(0, 0), cA, voffA); PG8_STAGE(PG8_SB(0, 1), cB + hstep, voffB); PG8_STAGE(PG8_SA(0, 1), cA + hstep, voffA);
        if (wr == 1) PG8_BAR;
        PG8_WAIT_V(4); PG8_BAR;
        PG8_STAGE(PG8_SB(1, 0), cB + kstep, voffB); PG8_STAGE(PG8_SA(1, 0), cA + kstep, voffA); PG8_STAGE(PG8_SB(1, 1), cB + hstep + kstep, voffB);
        PG8_WAIT_V(6); PG8_BAR;
    }
    for (;;) {
        const bool has_next = S.next(ui + 1, nxt);
        const char* nA = has_next ? (const char*)g.A + (size_t)nxt.pm * tstep : cA; const char* nB = has_next ? (const char*)g.Bt + (size_t)nxt.pn * tstep : cB;
        for (int t = 0; t < nt; t += 2) {
            const bool last = (t == nt - 2);
            const char* a1 = cA + (size_t)(t + 1) * kstep;
            const char* a2 = last ? nA : cA + (size_t)(t + 2) * kstep; const char* b2 = last ? nB : cB + (size_t)(t + 2) * kstep;
            const char* a3 = a2 + kstep; const char* b3 = b2 + kstep;
            if (last && has_next) S.a_ready(nxt);
            if constexpr (Epi::PREFETCH) { if (last) E.prefetch(pre_, cur, wr, fr); }
            if constexpr (SP2) {
            PG8_LDB(B0, 0, 0); PG8_LDB(B1, 0, 1); PG8_SCHED; PG8_LDA(At, 0, 0); PG8_STAGE(PG8_SA(1, 1), a1 + hstep, voffA);
            PG8_WAIT_V(8); PG8_WAIT_L(0); PG8_BAR; PG8_MMA(0, 0, At, B0); PG8_MMA(0, 1, At, B1); PG8_BAR; PG8_SCHED;
            PG8_LDA(At, 0, 1); PG8_STAGE(PG8_SB(0, 0), b2, voffB); PG8_STAGE(PG8_SB(0, 1), b2 + hstep, voffB); PG8_STAGE(PG8_SA(0, 0), a2, voffA);
            PG8_WAIT_V(8); PG8_WAIT_L(0); PG8_BAR; PG8_MMA(1, 0, At, B0); PG8_MMA(1, 1, At, B1); PG8_BAR; PG8_SCHED;
            PG8_LDB(B0, 1, 0); PG8_LDB(B1, 1, 1); PG8_SCHED; PG8_LDA(At, 1, 0); PG8_STAGE(PG8_SA(0, 1), a2 + hstep, voffA);
            PG8_WAIT_V(8); PG8_WAIT_L(0); PG8_BAR; PG8_MMA(0, 0, At, B0); PG8_MMA(0, 1, At, B1); PG8_BAR; PG8_SCHED;
            PG8_LDA(At, 1, 1); PG8_STAGE(PG8_SB(1, 0), b3, voffB); PG8_STAGE(PG8_SB(1, 1), b3 + hstep, voffB); PG8_STAGE(PG8_SA(1, 0), a3, voffA);
            PG8_WAIT_V(8); PG8_WAIT_L(0); PG8_BAR; PG8_MMA(1, 0, At, B0); PG8_MMA(1, 1, At, B1); PG8_BAR; PG8_SCHED;
            } else {
            PG8_LDB(B0, 0, 0); PG8_SCHED; PG8_LDA(At, 0, 0); PG8_STAGE(PG8_SA(1, 1), a1 + hstep, voffA);
            PG8_WAIT_L(8); PG8_BAR; PG8_WAIT_L(0); PG8_MMA(0, 0, At, B0); PG8_BAR; PG8_SCHED;
            PG8_LDB(B1, 0, 1); PG8_STAGE(PG8_SB(0, 0), b2, voffB);
            PG8_BAR; PG8_WAIT_L(0); PG8_MMA(0, 1, At, B1); PG8_BAR;
            PG8_LDA(At, 0, 1); PG8_STAGE(PG8_SA(0, 0), a2, voffA);
            PG8_BAR; PG8_WAIT_L(0); PG8_MMA(1, 0, At, B0); PG8_BAR; PG8_SCHED;
            PG8_STAGE(PG8_SB(0, 1), b2 + hstep, voffB);
            PG8_WAIT_V(6); PG8_BAR; PG8_MMA(1, 1, At, B1); PG8_BAR;
            PG8_LDB(B0, 1, 0); PG8_SCHED; PG8_LDA(At, 1, 0); PG8_STAGE(PG8_SA(0, 1), a2 + hstep, voffA);
            PG8_WAIT_L(8); PG8_BAR; PG8_WAIT_L(0); PG8_MMA(0, 0, At, B0); PG8_BAR; PG8_SCHED;
            PG8_LDB(B1, 1, 1); PG8_STAGE(PG8_SB(1, 0), b3, voffB);
            PG8_BAR; PG8_WAIT_L(0); PG8_MMA(0, 1, At, B1); PG8_BAR;
            PG8_LDA(At, 1, 1); PG8_STAGE(PG8_SA(1, 0), a3, voffA);
            PG8_BAR; PG8_WAIT_L(0); PG8_MMA(1, 0, At, B0); PG8_BAR; PG8_SCHED;
            PG8_STAGE(PG8_SB(1, 1), b3 + hstep, voffB);
            PG8_WAIT_V(6); PG8_BAR; PG8_MMA(1, 1, At, B1); PG8_BAR;
            }
        }
        if constexpr (ALIGN_EPI) { if (wr == 0) PG8_BAR; }
        if constexpr (!Epi::AFTER_DRAIN) { if constexpr (Epi::PREFETCH) E(acc, cur, wr, wc, fr, fq, pre_); else E(acc, cur, wr, wc, fr, fq); S.done(cur); }
        if (!has_next) break;
#pragma unroll
        for (int a = 0; a < 2; ++a)
#pragma unroll
            for (int b = 0; b < 2; ++b)
#pragma unroll
                for (int m = 0; m < 4; ++m)
#pragma unroll
                    for (int n = 0; n < 2; ++n) acc[a][b][m][n] = (f32x4){0.f, 0.f, 0.f, 0.f};
        cur = nxt; cA = nA; cB = nB; ++ui;
        if constexpr (ALIGN_EPI) { if (wr == 1) PG8_BAR; }
    }
    PG8_WAIT_V(0);
    if constexpr (!ALIGN_EPI) { if (wr == 0) PG8_BAR; }
    PG8_BAR;
    if constexpr (Epi::AFTER_DRAIN) { E.fused(acc, cur, wr, wc, fr, fq, lds, wid, lane); S.done(cur); }
#undef PG8_SA
#undef PG8_SB
#undef PG8_STAGE
#undef PG8_LDA
#undef PG8_LDB
#undef PG8_MMA
#undef PG8_WAIT_V
#undef PG8_WAIT_L
#undef PG8_BAR
#undef PG8_SCHED
}
}

constexpr size_t MiB = 1u << 20;
constexpr size_t WS_SS1 = 0  , WS_SS2 = 264 * 1024  , WS_BAR = 640 * 1024  , WS_CTL_BYTES = 704 * 1024;
constexpr size_t WS_WIN = 1 * MiB, WS_WOUT = 7 * MiB, WS_WGU = 9 * MiB, WS_WDN = 20 * MiB;
constexpr size_t WS_XN = 26 * MiB;
constexpr size_t WS_Q = 91 * MiB, WS_K = 124 * MiB, WS_V = 157 * MiB, WS_U = 190 * MiB, WS_B = 223 * MiB;
constexpr size_t WS_MIX = 256 * MiB;
constexpr size_t WS_ACT = 91 * MiB;
constexpr size_t WS_END = 321 * MiB;
static_assert(WS_SS1 + (size_t)MT * 8 <= WS_SS2 && WS_SS2 + (size_t)MT * 8 <= WS_BAR, "control map");
static_assert(WS_XN + (size_t)MT * DM * 2 <= WS_Q && WS_Q + (size_t)MT * DA * 2 <= WS_K && WS_MIX + (size_t)MT * DM * 2 <= WS_END && WS_ACT + (size_t)MT * DFF * 2 <= WS_END, "ws map");

constexpr int LDS_BYTES = 147456;
#define LAS __attribute__((address_space(3)))
typedef unsigned short bf16;
typedef short bf16x8 __attribute__((ext_vector_type(8)));
typedef float f32x4 __attribute__((ext_vector_type(4)));
typedef float f32x2 __attribute__((ext_vector_type(2)));
typedef float f32x16 __attribute__((ext_vector_type(16)));
typedef unsigned u32x4 __attribute__((ext_vector_type(4)));
typedef unsigned u32x2 __attribute__((ext_vector_type(2)));

__device__ __forceinline__ unsigned f2bf(float f) { unsigned u = __builtin_bit_cast(unsigned, f); return (u + 0x7fffu + ((u >> 16) & 1u)) >> 16; }
__device__ __forceinline__ unsigned pk2(float lo, float hi) { return f2bf(lo) | (f2bf(hi) << 16); }
typedef __bf16 bf16x2_t __attribute__((ext_vector_type(2)));
__device__ __forceinline__ unsigned cvtpk(float lo, float hi) { f32x2 v = {lo, hi}; bf16x2_t b = __builtin_convertvector(v, bf16x2_t); return __builtin_bit_cast(unsigned, b); }
__device__ __forceinline__ float bf2f(unsigned short x) { return __builtin_bit_cast(float, (unsigned)x << 16); }
__device__ __forceinline__ float bflo(unsigned w) { return __builtin_bit_cast(float, w << 16); }
__device__ __forceinline__ float bfhi(unsigned w) { return __builtin_bit_cast(float, w & 0xffff0000u); }
__device__ __forceinline__ float wave_sum(float v) {
#pragma unroll
    for (int o = 1; o < 64; o <<= 1) v += __shfl_xor(v, o);
    return v;
}
__device__ __forceinline__ float wave_max(float v) {
#pragma unroll
    for (int o = 1; o < 64; o <<= 1) v = fmaxf(v, __shfl_xor(v, o));
    return v;
}
#define LDS_FENCE() asm volatile("s_waitcnt lgkmcnt(0)" ::: "memory")

#define XB_TMO      128
#define XB_XCNT(j)  (256  + 64 * (j))
#define XB_XSUB(j)  (1280 + 64 * (j))
#define XB_XGEN(j)  (2304 + 64 * (j))
#define XB_TOP      3328
#define XB_TOPGEN   3392
#define XCD_BAR_WORDS 3456
#define XB_SPIN_CAP (1u << 18)

__device__ __forceinline__ unsigned xb_ld(unsigned* p)              { return __hip_atomic_load(p, __ATOMIC_RELAXED, __HIP_MEMORY_SCOPE_AGENT); }
__device__ __forceinline__ unsigned xb_add(unsigned* p, unsigned v) { return __hip_atomic_fetch_add(p, v, __ATOMIC_RELAXED, __HIP_MEMORY_SCOPE_AGENT); }
__device__ __forceinline__ unsigned xb_xcc_id() { return (unsigned)__builtin_amdgcn_s_getreg((3 << 11) | 20) & 0xFu; }
#define XB_SPIN(cond, bar) do { unsigned _sp = 0; while (cond) { __builtin_amdgcn_s_sleep(1); \
    if ((++_sp & 255u) == 0u) { if (xb_ld(&(bar)[XB_TMO])) break; if (_sp > XB_SPIN_CAP) { atomicAdd(&(bar)[XB_TMO], 1u); break; } } } } while (0)

struct XcdBarrier {
    unsigned* bar; unsigned x;
    volatile LAS unsigned* st;
};

__device__ __forceinline__ XcdBarrier xcd_barrier_post(unsigned* bar, volatile LAS unsigned* st) {
    XcdBarrier b; b.bar = bar; b.x = xb_xcc_id(); b.st = st;
    if (threadIdx.x == 0) (void)xb_add(&bar[XB_XCNT(b.x)], 1u);
    return b;
}
__device__ __forceinline__ void xcd_barrier_complete(unsigned* bar, unsigned x, unsigned& nloc, unsigned& nx) {
    const unsigned G = gridDim.x * gridDim.y * gridDim.z;
    unsigned sum, cnt, mine, sp = 0u;
    for (;;) {
        sum = 0u; cnt = 0u; mine = 0u;
#pragma unroll
        for (unsigned j = 0; j < 16; ++j) { const unsigned c = xb_ld(&bar[XB_XCNT(j)]); sum += c; cnt += (c > 0u) ? 1u : 0u; mine = (j == x) ? c : mine; }
        if (sum == G) break;
        __builtin_amdgcn_s_sleep(1);
        if ((++sp & 255u) == 0u) { if (xb_ld(&bar[XB_TMO])) break; if (sp > XB_SPIN_CAP) { atomicAdd(&bar[XB_TMO], 1u); break; } }
    }
    nloc = mine > 0u ? mine : 1u; nx = cnt > 0u ? cnt : 1u;
}

__device__ __forceinline__ void xcd_barrier(const XcdBarrier& b) {
    asm volatile("s_waitcnt vmcnt(0)" ::: "memory");
    __syncthreads();
    if (threadIdx.x == 0) {
        unsigned* bar = b.bar;
        __builtin_amdgcn_s_waitcnt(0);
        unsigned nloc = b.st[0], nx = b.st[1];
        if (nloc == 0u) { xcd_barrier_complete(bar, b.x, nloc, nx); b.st[0] = nloc; b.st[1] = nx; }
        const unsigned old = xb_add(&bar[XB_XSUB(b.x)], 1u);
        const unsigned gen = old / nloc;
        if (old + 1u == (gen + 1u) * nloc) {
            __builtin_amdgcn_fence(__ATOMIC_RELEASE, "agent");
            asm volatile("s_waitcnt vmcnt(0)" ::: "memory");
            const unsigned og = xb_add(&bar[XB_TOP], 1u);
            const unsigned tg = og / nx;
            if (og + 1u == (tg + 1u) * nx) xb_add(&bar[XB_TOPGEN], 1u);
            else XB_SPIN(xb_ld(&bar[XB_TOPGEN]) == tg, bar);
            __builtin_amdgcn_fence(__ATOMIC_ACQUIRE, "agent");
            xb_add(&bar[XB_XGEN(b.x)], 1u);
            asm volatile("s_waitcnt vmcnt(0)" ::: "memory");
        } else {
            XB_SPIN(xb_ld(&bar[XB_XGEN(b.x)]) == gen, bar);
            __builtin_amdgcn_fence(__ATOMIC_ACQUIRE, "agent");
            asm volatile("s_waitcnt vmcnt(0)" ::: "memory");
        }
    }
    __syncthreads();
}

__device__ __forceinline__ void transpose_item(const float* W, int ldw, int K, bf16* WT, int drow0, int scol0, int kb, LAS float* scr, int lane) {
    const int k0 = 64 * kb;
#pragma unroll
    for (int i = 0; i < 32; ++i) { const int kk = 2 * i + (lane >> 5); scr[kk * 33 + (lane & 31)] = __builtin_nontemporal_load(W + (size_t)(k0 + kk) * ldw + scol0 + (lane & 31)); }
    LDS_FENCE();
    const int c = lane & 7;
#pragma unroll
    for (int j = 0; j < 4; ++j) { const int n = (lane >> 3) + 8 * j; const LAS float* s = scr + (8 * c) * 33 + n;
        u32x4 o; o.x = pk2(s[0 * 33], s[1 * 33]); o.y = pk2(s[2 * 33], s[3 * 33]); o.z = pk2(s[4 * 33], s[5 * 33]); o.w = pk2(s[6 * 33], s[7 * 33]);
        *(u32x4*)(WT + (size_t)(drow0 + n) * K + k0 + 8 * c) = o; }
    LDS_FENCE();
}
__device__ __forceinline__ void rms_rows2_to_bf16(const float* xrow0, const float* xrow1, const float* g, bf16* orow0, bf16* orow1, int lane) {
    const f32x4* gr = (const f32x4*)g + lane;
    f32x4 v[2][4]; float s[2] = {0.f, 0.f};
#pragma unroll
    for (int k = 0; k < 2; ++k) { const float* xr_ = k ? xrow1 : xrow0; if (xr_) { const f32x4* xr = (const f32x4*)xr_ + lane;
#pragma unroll
        for (int j = 0; j < 4; ++j) v[k][j] = __builtin_nontemporal_load(xr + 64 * j); } }
#pragma unroll
    for (int k = 0; k < 2; ++k) { if (k ? xrow1 != nullptr : true) {
#pragma unroll
        for (int j = 0; j < 4; ++j) s[k] += (v[k][j].x * v[k][j].x + v[k][j].y * v[k][j].y) + (v[k][j].z * v[k][j].z + v[k][j].w * v[k][j].w); } }
#pragma unroll
    for (int k = 0; k < 2; ++k) { bf16* orow = k ? orow1 : orow0; if (k && !xrow1) continue;
        const float rs = 1.0f / sqrtf(wave_sum(s[k]) * (1.0f / DM) + RMS_EPS);
        unsigned long long* o8 = (unsigned long long*)orow + lane;
#pragma unroll
        for (int j = 0; j < 4; ++j) { const f32x4 gg = gr[64 * j];
            o8[64 * j] = (unsigned long long)cvtpk(v[k][j].x * rs * gg.x, v[k][j].y * rs * gg.y) | ((unsigned long long)cvtpk(v[k][j].z * rs * gg.z, v[k][j].w * rs * gg.w) << 32); } }
}

constexpr int AT_PO = 0, AT_ML = 65536, AT_VST = 69632, AT_VST_W = 9216;
__device__ __forceinline__ int po_off(int slot, int g4) { return slot * 128 + (((g4 ^ (slot ^ (slot >> 4))) & 15) << 3); }

typedef short s16x4 __attribute__((ext_vector_type(4)));
__device__ __forceinline__ s16x4 vtr(const LAS unsigned short* p) { return __builtin_bit_cast(s16x4, __builtin_amdgcn_ds_read_tr16_b64_v4i16((LAS s16x4*)p)); }
struct AtP { const bf16* Qh; const bf16* Kh; const bf16* Vh; bf16* Oh; float sl2; int st, d, c, eq0, slot0, sstride; };
__device__ __forceinline__ AtP at_params(int g, int vcu, int G, int wave, const bf16* Q, const bf16* K, const bf16* V, bf16* MIX) {
    const int ui = g / 6, n = g - 6 * ui, u = vcu + ui * G, b = u >> 5, h = (u >> 2) & 7, blk = (ui & 1) ? 3 - (u & 3) : (u & 3)  , st = n >> 1, tau = wave + 8 * (n & 1);
    const size_t rb = (size_t)b * 2048;
    AtP p; p.Qh = Q + rb * DA + h * 64; p.Kh = K + rb * DA + h * 64; p.Vh = V + rb * DA + h * 64; p.Oh = MIX + (rb + 512 * blk) * DM + h * 64;
    p.sl2 = __builtin_amdgcn_exp2f(-(float)(h + 1)) * LOG2E; p.st = st;
    if (st == 0)      { p.d = 16; p.c = tau;     p.eq0 = 32 * blk;                    p.slot0 = tau;                          p.sstride = 16; }
    else if (st == 1) { p.d = 4;  p.c = tau & 3; p.eq0 = 128 * blk + 32 * (tau >> 2); p.slot0 = (tau & 3) + 128 * (tau >> 2); p.sstride = 4; }
    else              { p.d = 1;  p.c = 0;       p.eq0 = 512 * blk + 32 * tau;        p.slot0 = 32 * tau;                     p.sstride = 1; }
    return p;
}
__device__ __forceinline__ void attn_prompt_all(LAS unsigned char* lds, int vcu, int G, const bf16* Q, const bf16* K, const bf16* V, bf16* MIX) {
    const int tid = threadIdx.x, lane = tid & 63, wave = __builtin_amdgcn_readfirstlane(tid >> 6), r32 = lane & 31, hi = lane >> 5;
    LAS unsigned short* vs = (LAS unsigned short*)(lds + AT_VST + wave * AT_VST_W);
    LAS unsigned short* ks = vs + 2304;
    LAS f32x2* ML = (LAS f32x2*)(lds + AT_ML);
    const int nunits = (512 - vcu + G - 1) / G, T = 6 * nunits;
    const int th = r32 - 4 * hi;
    bf16x8 qn[4]; u32x4 kn[4], vn[4];
#define AT_LOADQ(P) do { const bf16* qp_ = (P).Qh + (size_t)((P).c + (P).d * ((P).eq0 + r32)) * DA + 8 * hi; \
        _Pragma("unroll") for (int d0 = 0; d0 < 4; ++d0) qn[d0] = *(const bf16x8*)(qp_ + 16 * d0); } while (0)
#define AT_LOAD(P, kt) do { const int e0_ = (P).eq0 - 128 + 32 * (kt); \
        _Pragma("unroll") for (int j = 0; j < 4; ++j) { const size_t ro_ = (size_t)((P).c + (P).d * (e0_ + (lane >> 3) + 8 * j)) * DA + 8 * (lane & 7); \
            kn[j] = *(const u32x4*)((P).Kh + ro_); vn[j] = *(const u32x4*)((P).Vh + ro_); } } while (0)
    AtP nx = at_params(0, vcu, G, wave, Q, K, V, MIX);
    if (T > 0) { AT_LOADQ(nx); AT_LOAD(nx, 4); }
#pragma unroll 1
    for (int g = 0; g < T; ++g) {
        const AtP p = nx;
        bf16x8 qf[4];
#pragma unroll
        for (int d0 = 0; d0 < 4; ++d0) qf[d0] = qn[d0];
        const bool have_next = g + 1 < T;
        if (have_next) { nx = at_params(g + 1, vcu, G, wave, Q, K, V, MIX); AT_LOADQ(nx); }
        float m = -4096.0f, l = 0.f; f32x16 o0, o1;
#pragma unroll
        for (int r = 0; r < 16; ++r) { o0[r] = 0.f; o1[r] = 0.f; }
        int kt0 = (128 - p.eq0) / 32; if (kt0 < 0) kt0 = 0;
        const float sld = p.sl2 * (float)p.d;
        f32x16 cst;
#pragma unroll
        for (int r = 0; r < 16; ++r) cst[r] = sld * (float)((r & 3) + 8 * (r >> 2));
#pragma unroll 1
        for (int kt = 4; kt >= kt0; --kt) {
            LDS_FENCE();
#pragma unroll
            for (int j = 0; j < 4; ++j) { const int key = (lane >> 3) + 8 * j, vrow = (key & 0x13) | ((key & 4) << 1) | ((key & 8) >> 1);
                *(LAS u32x4*)(vs + vrow * 72 + 8 * (lane & 7)) = vn[j]; *(LAS u32x4*)(ks + key * 72 + 8 * (lane & 7)) = kn[j]; }
            if (kt > kt0) AT_LOAD(p, kt - 1); else if (have_next) AT_LOAD(nx, 4);
            LDS_FENCE();
            bf16x8 kc[4];
#pragma unroll
            for (int d0 = 0; d0 < 4; ++d0) kc[d0] = *(const LAS bf16x8*)(ks + r32 * 72 + 16 * d0 + 8 * hi);
            __builtin_amdgcn_sched_barrier(0);
            const float b0 = -sld * (float)(128 - 32 * kt + th) - m;
            f32x16 s;
#pragma unroll
            for (int r = 0; r < 16; ++r) s[r] = cst[r] + b0;
            __builtin_amdgcn_s_setprio(1);
#pragma unroll
            for (int d0 = 0; d0 < 4; ++d0) s = __builtin_amdgcn_mfma_f32_32x32x16_bf16(kc[d0], qf[d0], s, 0, 0, 0);
            __builtin_amdgcn_s_setprio(0);
            if (kt == 4) {
#pragma unroll
                for (int r = 0; r < 16; ++r) s[r] = ((r & 3) + 8 * (r >> 2) <= th) ? s[r] : -3e38f; }
            if (kt == 0) {
#pragma unroll
                for (int r = 0; r < 16; ++r) s[r] = ((r & 3) + 8 * (r >> 2) >= th) ? s[r] : -3e38f; }
            float mt = s[0];
#pragma unroll
            for (int r = 1; r < 16; ++r) mt = fmaxf(mt, s[r]);
            { auto rr = __builtin_amdgcn_permlane32_swap(__float_as_uint(mt), __float_as_uint(mt), false, false); mt = fmaxf(__uint_as_float(rr[0]), __uint_as_float(rr[1])); }
            if (__any(mt > 0.f)) {
                const float dl = fmaxf(mt, 0.f), alpha = __builtin_amdgcn_exp2f(-dl);
                m += dl; l *= alpha;
#pragma unroll
                for (int r = 0; r < 16; ++r) { s[r] -= dl; o0[r] *= alpha; o1[r] *= alpha; }
            }
            float ls = 0.f;
#pragma unroll
            for (int r = 0; r < 16; ++r) { s[r] = __builtin_amdgcn_exp2f(s[r]); ls += s[r]; }
            l += ls;
            bf16x8 pf[2];
#pragma unroll
            for (int s2 = 0; s2 < 2; ++s2) { u32x4 w; w.x = cvtpk(s[8 * s2 + 0], s[8 * s2 + 1]); w.y = cvtpk(s[8 * s2 + 2], s[8 * s2 + 3]); w.z = cvtpk(s[8 * s2 + 4], s[8 * s2 + 5]); w.w = cvtpk(s[8 * s2 + 6], s[8 * s2 + 7]);
                pf[s2] = __builtin_bit_cast(bf16x8, w); }
#pragma unroll
            for (int s2 = 0; s2 < 2; ++s2) {
                const LAS unsigned short* tb = vs + (16 * s2 + 8 * hi + ((lane & 15) >> 2)) * 72 + 16 * ((lane >> 4) & 1) + 4 * (lane & 3);
                const s16x4 a0 = vtr(tb), a1 = vtr(tb + 4 * 72), b0_ = vtr(tb + 32), b1_ = vtr(tb + 4 * 72 + 32);
                const bf16x8 v0 = __builtin_shufflevector(a0, a1, 0, 1, 2, 3, 4, 5, 6, 7), v1 = __builtin_shufflevector(b0_, b1_, 0, 1, 2, 3, 4, 5, 6, 7);
                __builtin_amdgcn_s_setprio(1);
                o0 = __builtin_amdgcn_mfma_f32_32x32x16_bf16(v0, pf[s2], o0, 0, 0, 0);
                o1 = __builtin_amdgcn_mfma_f32_32x32x16_bf16(v1, pf[s2], o1, 0, 0, 0);
                __builtin_amdgcn_s_setprio(0);
            }
        }
        { auto rr = __builtin_amdgcn_permlane32_swap(__float_as_uint(l), __float_as_uint(l), false, false); l = __uint_as_float(rr[0]) + __uint_as_float(rr[1]); }
        const int slot = p.slot0 + p.sstride * r32, st = p.st;
        float ca, cb;
        if (st == 0) { ca = 1.0f / l; cb = 0.f; if (hi == 0) ML[slot] = (f32x2){m, l}; }
        else { const f32x2 ml = ML[slot]; const float M = fmaxf(m, ml.x), e1 = __builtin_amdgcn_exp2f(m - M), wn = l * e1, wo = ml.y * __builtin_amdgcn_exp2f(ml.x - M), inv = 1.0f / (wn + wo);
            ca = e1 * inv; cb = wo * inv; LDS_FENCE(); if (hi == 0) ML[slot] = (f32x2){M, wn + wo}; }
#pragma unroll
        for (int nh = 0; nh < 2; ++nh)
#pragma unroll
            for (int rg = 0; rg < 4; ++rg) {
                const int g4 = 8 * nh + 2 * rg + hi;
                LAS u32x2* pp = (LAS u32x2*)(lds + AT_PO + po_off(slot, g4));
                float v[4];
#pragma unroll
                for (int e2 = 0; e2 < 4; ++e2) v[e2] = ca * (nh ? o1[4 * rg + e2] : o0[4 * rg + e2]);
                if (st != 0) { const u32x2 old = *pp; v[0] += cb * bflo(old.x); v[1] += cb * bfhi(old.x); v[2] += cb * bflo(old.y); v[3] += cb * bfhi(old.y); }
                u32x2 w; w.x = cvtpk(v[0], v[1]); w.y = cvtpk(v[2], v[3]);
                if (st != 2) *pp = w;
                else *(u32x2*)(p.Oh + (size_t)slot * DM + 4 * g4) = w;
            }
        if (g & 1) asm volatile("s_waitcnt lgkmcnt(0)\n\ts_barrier" ::: "memory");
    }
#undef AT_LOADQ
#undef AT_LOAD
}

__device__ __forceinline__ void attn_sample_bh(LAS unsigned char* lds, int b, int h, const bf16* Q, const float* sk, const float* sv, const float* outp, bf16* MIX) {
    LAS float* qs = (LAS float*)lds;
    LAS float* sb = qs + 256;
    LAS float* lb = sb + 4 * 388;
    LAS float* red = lb + 16;
    const int tid = threadIdx.x, lane = tid & 63, wave = tid >> 6;
    if (tid < 256) qs[tid] = bf2f(Q[(size_t)(MP + b * 4 + (tid >> 6)) * DA + h * 64 + (tid & 63)]);
    __syncthreads();
    const float sl2 = __builtin_amdgcn_exp2f(-(float)(h + 1)) * LOG2E;
    {
        const int sub = tid & 3, grp = tid >> 2;
#pragma unroll 2
        for (int pi = grp; pi < 4 * 387; pi += 128) {
            const int i = pi / 387, rem = pi - i * 387, br = rem / 129, j = rem - br * 129, d = 1 << (2 * br), idx = 2048 + i - d * j;
            const float* kr = idx < 2048 ? sk + ((size_t)(b * 2048 + idx) * 8 + h) * 64 : outp + O_KS + (size_t)(b * 4 + idx - 2048) * DA + h * 64;
            float dot = 0.f;
#pragma unroll
            for (int c4 = 0; c4 < 4; ++c4) { const f32x4 kv = *(const f32x4*)(kr + 16 * c4 + 4 * sub); const LAS float* qq = qs + i * 64 + 16 * c4 + 4 * sub;
                dot += (kv.x * qq[0] + kv.y * qq[1]) + (kv.z * qq[2] + kv.w * qq[3]); }
            dot += __shfl_xor(dot, 1); dot += __shfl_xor(dot, 2);
            if (sub == 0) sb[i * 388 + rem] = dot - sl2 * (float)(d * j);
        }
    }
    __syncthreads();
    if (wave < 4) {
        float v[7], mx = -1e30f;
#pragma unroll
        for (int k = 0; k < 7; ++k) { const int idx = lane + 64 * k; v[k] = idx < 387 ? sb[wave * 388 + idx] : -1e30f; mx = fmaxf(mx, v[k]); }
        mx = wave_max(mx); float s = 0.f;
#pragma unroll
        for (int k = 0; k < 7; ++k) { const int idx = lane + 64 * k; const float p = __builtin_amdgcn_exp2f(v[k] - mx); if (idx < 387) { sb[wave * 388 + idx] = p; s += p; } }
        s = wave_sum(s); if (lane == 0) lb[wave] = s;
    }
    __syncthreads();
    { const int i = tid >> 7, kg = (tid & 127) >> 4, ch = tid & 15; f32x4 acc = {0.f, 0.f, 0.f, 0.f};
#pragma unroll 4
      for (int jj = kg; jj < 387; jj += 8) { const int br = jj / 129, j = jj - br * 129, d = 1 << (2 * br), idx = 2048 + i - d * j;
          const float* vr = idx < 2048 ? sv + ((size_t)(b * 2048 + idx) * 8 + h) * 64 : outp + O_VS + (size_t)(b * 4 + idx - 2048) * DA + h * 64;
          const f32x4 vv = *(const f32x4*)(vr + 4 * ch); acc += vv * sb[i * 388 + jj]; }
      *(LAS f32x4*)(red + (i * 8 + kg) * 64 + 4 * ch) = acc; }
    __syncthreads();
    if (tid < 256) { const int i = tid >> 6, dd = tid & 63; float s = 0.f;
#pragma unroll
        for (int kg = 0; kg < 8; ++kg) s += red[(i * 8 + kg) * 64 + dd];
        MIX[(size_t)(MP + b * 4 + i) * DM + h * 64 + dd] = (bf16)f2bf(s / lb[i]); }
    __syncthreads();
}

__device__ __forceinline__ void unpack8(const u32x4 w, float* f) { f[0] = bflo(w.x); f[1] = bfhi(w.x); f[2] = bflo(w.y); f[3] = bfhi(w.y); f[4] = bflo(w.z); f[5] = bfhi(w.z); f[6] = bflo(w.w); f[7] = bfhi(w.w); }
__device__ __forceinline__ void conv_rows(int vb, int G, const bf16* U, const bf16* Bg, const float* wconv, const float* sconv, bf16* MIX) {
    const int tid = threadIdx.x, rsub = tid >> 6, c8 = (tid & 63) * 8;
    float w0[8], w1[8], w2[8];
#pragma unroll
    for (int e = 0; e < 8; ++e) { w0[e] = wconv[c8 + e]; w1[e] = wconv[512 + c8 + e]; w2[e] = wconv[1024 + c8 + e]; }
    for (int r = vb * 8 + rsub; r < MV; r += G * 8) {
        float u2[8], u1[8], u0[8], gb[8];
        unpack8(*(const u32x4*)(U + (size_t)r * DA + c8), u2); unpack8(__builtin_nontemporal_load((const u32x4*)(Bg + (size_t)r * DA + c8)), gb);
        int i; const float* s1 = nullptr; const float* s0 = nullptr;
        if (r < MP) i = r & 2047;
        else { const int rr = r - MP; i = rr & 3; const float* sc = sconv + (size_t)(rr >> 2) * 1024 + c8; s1 = sc + 512; s0 = sc + (i == 0 ? 0 : 512); }
        if (i >= 1) unpack8(*(const u32x4*)(U + (size_t)(r - 1) * DA + c8), u1);
        else {
#pragma unroll
            for (int e = 0; e < 8; ++e) u1[e] = s1 ? s1[e] : 0.f; }
        if (i >= 2) unpack8(*(const u32x4*)(U + (size_t)(r - 2) * DA + c8), u0);
        else {
#pragma unroll
            for (int e = 0; e < 8; ++e) u0[e] = s0 ? s0[e] : 0.f; }
        float o[8];
#pragma unroll
        for (int e = 0; e < 8; ++e) o[e] = gb[e] * (w0[e] * u0[e] + w1[e] * u1[e] + w2[e] * u2[e]);
        u32x4 w; w.x = pk2(o[0], o[1]); w.y = pk2(o[2], o[3]); w.z = pk2(o[4], o[5]); w.w = pk2(o[6], o[7]);
        *(u32x4*)(MIX + (size_t)r * DM + 512 + c8) = w;
    }
}

template <int NKS  , class Epi>
__device__ __forceinline__ void thin_gemm(LAS unsigned char* lds, int vcu, int G, const bf16* A  , const bf16* Bt, int npn, const Epi& E) {
    constexpr int K = NKS * 128;
    const int tid = threadIdx.x, lane = tid & 63, wave = __builtin_amdgcn_readfirstlane(tid >> 6), r32 = lane & 31, hi = lane >> 5;
    LAS f32x4* red = (LAS f32x4*)lds;
    for (int t = vcu; t < npn * 16; t += G) {
        const int rb = t & 3, c32 = (t >> 2) & 3, pn = t >> 4;
        const bf16* ap = A + (size_t)(32 * rb + r32) * K + wave * (NKS * 16) + 8 * hi;
        const bf16* bp = Bt + (size_t)(256 * pn + 32 * c32 + r32) * K + wave * (NKS * 16) + 8 * hi;
        f32x16 a0, a1;
#pragma unroll
        for (int r = 0; r < 16; ++r) { a0[r] = 0.f; a1[r] = 0.f; }
        constexpr int CH = (NKS == 8) ? 8 : 11;
#pragma unroll
        for (int s0 = 0; s0 < NKS; s0 += CH) {
            bf16x8 af[CH], b0[CH], b1[CH];
#pragma unroll
            for (int s = 0; s < CH; ++s) { af[s] = *(const bf16x8*)(ap + 16 * (s0 + s)); b0[s] = *(const bf16x8*)(bp + 16 * (s0 + s)); b1[s] = *(const bf16x8*)(bp + (size_t)128 * K + 16 * (s0 + s)); }
            __builtin_amdgcn_sched_barrier(0);
#pragma unroll
            for (int s = 0; s < CH; ++s) {
                a0 = __builtin_amdgcn_mfma_f32_32x32x16_bf16(b0[s], af[s], a0, 0, 0, 0);
                a1 = __builtin_amdgcn_mfma_f32_32x32x16_bf16(b1[s], af[s], a1, 0, 0, 0);
            }
            __builtin_amdgcn_sched_barrier(0);
        }
#pragma unroll
        for (int rg = 0; rg < 4; ++rg) {
            red[((wave * 2 + 0) * 4 + rg) * 64 + lane] = (f32x4){a0[4 * rg], a0[4 * rg + 1], a0[4 * rg + 2], a0[4 * rg + 3]};
            red[((wave * 2 + 1) * 4 + rg) * 64 + lane] = (f32x4){a1[4 * rg], a1[4 * rg + 1], a1[4 * rg + 2], a1[4 * rg + 3]};
        }
        __syncthreads();
        if (tid < 256) {
            const int rg = tid >> 6; f32x4 v0 = {0.f, 0.f, 0.f, 0.f}, v1 = {0.f, 0.f, 0.f, 0.f};
#pragma unroll
            for (int w = 0; w < 8; ++w) { v0 += red[((w * 2 + 0) * 4 + rg) * 64 + lane]; v1 += red[((w * 2 + 1) * 4 + rg) * 64 + lane]; }
            E.thin(MP + 32 * rb + r32, pn, 32 * c32 + 8 * rg + 4 * hi, v0, v1);
        }
        __syncthreads();
    }
}

struct Args { const float* in[14]; float* out; unsigned char* ws; };
__global__ void __launch_bounds__(512, 2) fwd_kernel(Args a) {
    extern __shared__ __attribute__((aligned(16))) unsigned char lds_raw[];
    LAS unsigned char* lds = (LAS unsigned char*)lds_raw;
    cg::grid_group grid = cg::this_grid();
    const int tid = threadIdx.x, lane = tid & 63, wave = __builtin_amdgcn_readfirstlane(tid >> 6);
    const int G = gridDim.x, bx = blockIdx.x;
    const int vcu = (G % 8 == 0) ? (bx % 8) * (G / 8) + bx / 8 : bx;
    unsigned char* ws = a.ws;
    const float* x_p = a.in[0]; const float* x_s = a.in[1]; const float* st_k = a.in[2]; const float* st_v = a.in[3]; const float* st_c = a.in[4];
    const float* g_mix = a.in[5]; const float* w_in = a.in[6]; const float* w_conv = a.in[7]; const float* w_out = a.in[8]; const float* g_ffn = a.in[9];
    const float* w_gate = a.in[10]; const float* w_up = a.in[11]; const float* w_down = a.in[12]; const float* g_fin = a.in[13];
    float* out = a.out;
    unsigned long long* ss1 = (unsigned long long*)(ws + WS_SS1); unsigned long long* ss2 = (unsigned long long*)(ws + WS_SS2);
    bf16* Win = (bf16*)(ws + WS_WIN); bf16* Wout = (bf16*)(ws + WS_WOUT); bf16* Wgu = (bf16*)(ws + WS_WGU); bf16* Wdn = (bf16*)(ws + WS_WDN);
    bf16* XN = (bf16*)(ws + WS_XN); bf16* Qb = (bf16*)(ws + WS_Q); bf16* Kb = (bf16*)(ws + WS_K); bf16* Vb = (bf16*)(ws + WS_V);
    bf16* Ub = (bf16*)(ws + WS_U); bf16* Bb = (bf16*)(ws + WS_B); bf16* MIX = (bf16*)(ws + WS_MIX); bf16* ACT = (bf16*)(ws + WS_ACT);

    volatile LAS unsigned* MISC = (volatile LAS unsigned*)(lds + LDS_BYTES - 128);
    if (tid < 32) MISC[tid] = 0u;
    __syncthreads();
    {
        LAS float* scr = (LAS float*)(lds + wave * 16384);
        const int gw = vcu * 8 + wave, NGW = G * 8;
        constexpr int I_IN = 16 * 96, I_OUT = 16 * 32, I_GU = 16 * 176, I_DN = 44 * 32, NITEMS = I_IN + I_OUT + I_GU + I_DN;
        for (int it = gw; it < NITEMS; it += NGW) {
            int r = it;
            if (r < I_IN) { const int kb = r / 96, db = r % 96, rho = 32 * db; int sc;
                if (rho < 1536) sc = rho;
                else if (rho < 2560) { const int j = (rho - 1536) >> 8, w = (rho - 1536) & 255; sc = w < 128 ? 1536 + 128 * j + w : 2560 + 128 * j + (w - 128); }
                else sc = 2048 + (rho - 2560);
                transpose_item(w_in, DIN, DM, Win, rho, sc, kb, scr, lane); continue; }
            r -= I_IN;
            if (r < I_OUT) { const int kb = r / 32, db = r % 32; transpose_item(w_out, DM, DM, Wout, 32 * db, 32 * db, kb, scr, lane); continue; }
            r -= I_OUT;
            if (r < I_GU) { const int kb = r / 176, db = r % 176, rho = 32 * db, pn = rho >> 8, w = rho & 255;
                transpose_item(w < 128 ? w_gate : w_up, DFF, DM, Wgu, rho, 128 * pn + (w & 127), kb, scr, lane); continue; }
            r -= I_GU;
            { const int kb = r / 32, db = r % 32; transpose_item(w_down, DM, DFF, Wdn, 32 * db, 32 * db, kb, scr, lane); }
        }
        for (int m = gw; m < MT; m += 2 * NGW) {
            const int m1 = m + NGW;
            const float* x0 = m < MV ? (m < MP ? x_p + (size_t)m * DM : x_s + (size_t)(m - MP) * DM) : nullptr;
            const float* x1 = m1 < MV ? (m1 < MP ? x_p + (size_t)m1 * DM : x_s + (size_t)(m1 - MP) * DM) : nullptr;
            if (x0) rms_rows2_to_bf16(x0, x1, g_mix, XN + (size_t)m * DM, XN + (size_t)m1 * DM, lane);
        }
    }
    { unsigned long long* ctl = (unsigned long long*)ws; for (int i = bx * 512 + tid; i < (int)(WS_CTL_BYTES / 8); i += G * 512) ctl[i] = 0ull; }
    __syncthreads();
    grid.sync();
    XcdBarrier bar = xcd_barrier_post((unsigned*)(ws + WS_BAR), MISC + 8);

    {
        pg8::Gemm g{XN, Win, MP, DIN, DM}; pg8::StaticOrder S; S.init(MP, DIN, G, bx);
        pg8::EpiIn E{Qb, Kb, Vb, Ub, Bb, out};
        thin_gemm<8>(lds, vcu, G, XN + (size_t)MP * DM, Win, DIN / 256, E);
        pg8::gemm_phase<pg8::EpiIn, pg8::StaticOrder, true, true>(lds, g, S, E);
    }
    xcd_barrier(bar);

    {
        if (vcu & 1) { for (int bh = vcu; bh < 256; bh += G) attn_sample_bh(lds, bh >> 3, bh & 7, Qb, st_k, st_v, out, MIX); }
        attn_prompt_all(lds, vcu, G, Qb, Kb, Vb, MIX);
        if (!(vcu & 1)) { for (int bh = vcu; bh < 256; bh += G) attn_sample_bh(lds, bh >> 3, bh & 7, Qb, st_k, st_v, out, MIX); }
        conv_rows(vcu, G, Ub, Bb, w_conv, st_c, MIX);
    }
    xcd_barrier(bar);

    {
        pg8::Gemm g{MIX, Wout, MP, DM, DM}; pg8::StaticOrder S; S.init(MP, DM, G, bx);
        pg8::EpiOut E{x_p, x_s, out, XN, g_ffn, ss1};
        thin_gemm<8>(lds, vcu, G, MIX + (size_t)MP * DM, Wout, DM / 256, E);
        pg8::gemm_phase<pg8::EpiOut, pg8::StaticOrder, true, true>(lds, g, S, E);
    }
    xcd_barrier(bar);

    {
        pg8::Gemm g{XN, Wgu, MP, 2 * DFF, DM}; pg8::StaticOrder S; S.init(MP, 2 * DFF, G, bx);
        pg8::EpiGU E{ACT, ss1};
        thin_gemm<8>(lds, vcu, G, XN + (size_t)MP * DM, Wgu, 2 * DFF / 256, E);
        pg8::gemm_phase<pg8::EpiGU, pg8::StaticOrder, true, true>(lds, g, S, E);
    }
    xcd_barrier(bar);

    {
        pg8::Gemm g{ACT, Wdn, MP, DM, DFF}; pg8::StaticOrder S; S.init(MP, DM, G, bx);
        pg8::EpiDown E{out, ss2, XN, g_ffn, g_fin};
        thin_gemm<22>(lds, vcu, G, ACT + (size_t)MP * DFF, Wdn, DM / 256, E);
        pg8::gemm_phase<pg8::EpiDown, pg8::StaticOrder, true, true>(lds, g, S, E);
    }
}

extern "C" void kernel_launch(void* const* d_in, const int* in_sizes, int n_in, void* d_out, int out_size, void* d_ws, size_t ws_size, hipStream_t stream) {
    static int grid = 0;
    if (grid == 0) {
        if (n_in != 14 || (size_t)out_size != O_END || ws_size < WS_END) { fprintf(stderr, "kernel_launch: unexpected shapes (n_in %d, out %d, ws %zu)\n", n_in, out_size, ws_size); grid = -1; return; }
        int dev = 0, cus = 0, per_cu = 0;
        hipGetDevice(&dev); hipDeviceGetAttribute(&cus, hipDeviceAttributeMultiprocessorCount, dev);
        if (hipFuncSetAttribute((const void*)fwd_kernel, hipFuncAttributeMaxDynamicSharedMemorySize, LDS_BYTES) != hipSuccess) { fprintf(stderr, "kernel_launch: hipFuncSetAttribute failed\n"); grid = -1; return; }
        if (hipOccupancyMaxActiveBlocksPerMultiprocessor(&per_cu, (const void*)fwd_kernel, 512, LDS_BYTES) != hipSuccess || per_cu < 1) { fprintf(stderr, "kernel_launch: occupancy query gave %d\n", per_cu); per_cu = 1; }
        (void)hipGetLastError();
        grid = cus * 1;
        if (grid <= 0) grid = 256;
    }
    if (grid < 0) return;
    Args a{};
    for (int i = 0; i < 14; ++i) a.in[i] = (const float*)d_in[i];
    a.out = (float*)d_out; a.ws = (unsigned char*)d_ws;
    void* args[] = {&a};
    hipError_t e = hipLaunchCooperativeKernel((const void*)fwd_kernel, dim3(grid), dim3(512), args, LDS_BYTES, stream);
    if (e != hipSuccess) fprintf(stderr, "cooperative launch failed: %s (grid %d)\n", hipGetErrorString(e), grid);
}
```

```cpp
#include <hip/hip_runtime.h>
#include <hip/hip_cooperative_groups.h>
#include <cstdio>
#include <cstdint>
namespace cg = cooperative_groups;

constexpr int MP = 32768;
constexpr int MSR = 128;
constexpr int MV = MP + MSR;
constexpr int MT = MP + 256;
constexpr int DM = 1024, DA = 512, DIN = 3072, DFF = 2816;
constexpr float RMS_EPS = 1e-6f;
constexpr float LOG2E = 1.4426950408889634f;
constexpr float QSCALE = 0.125f * LOG2E;
constexpr size_t O_Y = 0;
constexpr size_t O_KP = (size_t)MV * DM;
constexpr size_t O_VP = O_KP + (size_t)MP * DA;
constexpr size_t O_CP = O_VP + (size_t)MP * DA;
constexpr size_t O_KS = O_CP + 16 * 2 * 512;
constexpr size_t O_VS = O_KS + (size_t)MSR * DA;
constexpr size_t O_CS = O_VS + (size_t)MSR * DA;
constexpr size_t O_END = O_CS + 32 * 2 * 512;
namespace pg8 {
#define PG8_LAS __attribute__((address_space(3)))
typedef unsigned short bf16_t;
typedef short bf16x8 __attribute__((ext_vector_type(8)));
typedef float f32x4 __attribute__((ext_vector_type(4)));
typedef unsigned u32x4 __attribute__((ext_vector_type(4)));
constexpr int BM = 256, BK = 64, HALF = 128, HTB = HALF * BK * 2  , STAGE_BYTES = 8 * HTB, NXCD = 8, WGM = 8;

__host__ __device__ __forceinline__ int lds_byte(int r, int c) { const int st = (r >> 4) * 2 + (c >> 5), rr = r & 15, cc = c & 31, ob = rr * 64 + cc * 2; return st * 1024 + (ob ^ (((ob >> 9) & 1) << 5)); }
__host__ __device__ __forceinline__ void stage_rc(int b, int& R, int& C) { const int st = b / 1024, sb = b % 1024, swz = sb ^ (((sb >> 9) & 1) << 5); R = (st >> 1) * 16 + swz / 64; C = (st & 1) * 32 + (swz % 64) / 2; }
__host__ __device__ __forceinline__ int perm32(int rho) { const int n = rho >> 4, i = rho & 15; return 8 * (i >> 2) + 4 * n + (i & 3); }

struct Unit { int pm, pn; };
struct Gemm { const bf16_t* A; const bf16_t* Bt; int M, N, K; };

struct StaticOrder {
    int nM, nN, nwg, G, c;
    __host__ __device__ void init(int M, int N, int G_, int c_) { nM = M / BM; nN = N / BM; nwg = nM * nN; G = G_; c = c_; }
    __host__ __device__ bool next(int i, Unit& u) const {
        const long L = (long)i * G + c; if (L >= nwg) return false;
        int wgid = (int)L; { const int q = nwg / NXCD, r = nwg % NXCD, xcd = wgid % NXCD, off = wgid / NXCD; wgid = (xcd < r ? xcd * (q + 1) : r * (q + 1) + (xcd - r) * q) + off; }
        const int nig = WGM * nN, gid = wgid / nig, fm = gid * WGM, gsz = (nM - fm) < WGM ? (nM - fm) : WGM;
        u.pm = fm + ((wgid % nig) % gsz); u.pn = (wgid % nig) / gsz; return true;
    }
    __device__ __forceinline__ void a_ready(const Unit&) const {}
    __device__ __forceinline__ void done(const Unit&) const {}
};

__device__ __forceinline__ unsigned cvt_pk_bf16(float lo, float hi) { unsigned r; asm volatile("v_cvt_pk_bf16_f32 %0, %1, %2" : "=v"(r) : "v"(lo), "v"(hi)); return r; }
typedef __bf16 bf16x2v __attribute__((ext_vector_type(2))); typedef float f32x2v __attribute__((ext_vector_type(2)));
__device__ __forceinline__ unsigned cvt2(float lo, float hi) { f32x2v v = {lo, hi}; bf16x2v b = __builtin_convertvector(v, bf16x2v); return __builtin_bit_cast(unsigned, b); }
__device__ __forceinline__ u32x4 pack8(const f32x4 a, const f32x4 b) { u32x4 w; w.x = cvt2(a[0], a[1]); w.y = cvt2(a[2], a[3]); w.z = cvt2(b[0], b[1]); w.w = cvt2(b[2], b[3]); return w; }
typedef unsigned u32x2 __attribute__((ext_vector_type(2)));
__device__ __forceinline__ u32x2 pack4(const f32x4 a) { u32x2 w; w.x = cvt2(a[0], a[1]); w.y = cvt2(a[2], a[3]); return w; }
__device__ __forceinline__ void st_nt(float* p, const f32x4 v) { __builtin_nontemporal_store(v, (f32x4*)p); }
__device__ __forceinline__ f32x4 ld_nt(const float* p) { return __builtin_nontemporal_load((const f32x4*)p); }
__device__ __forceinline__ float dot4(const f32x4 a) { return (a[0] * a[0] + a[1] * a[1]) + (a[2] * a[2] + a[3] * a[3]); }

struct EpiIn {
    static constexpr bool PERM = true, AFTER_DRAIN = false, PREFETCH = false; struct Pre {};
    bf16_t *Q, *K, *V, *U, *B; float* out;
    __device__ __forceinline__ void operator()(const f32x4 (&acc)[2][2][4][2], const Unit& u, int wr, int wc, int fr, int fq) const {
        const int row0 = u.pm * BM + wr * 64 + fr, pn = u.pn, cw = wc * 32 + 8 * fq;
#pragma unroll
        for (int ai = 0; ai < 2; ++ai)
#pragma unroll
            for (int m = 0; m < 4; ++m) {
                const int row = row0 + ai * HALF + m * 16;
                if (row >= MV) continue;
                if (pn < 2) {
#pragma unroll
                    for (int bj = 0; bj < 2; ++bj) { const int col = pn * 256 + bj * HALF + cw;
                        *(u32x4*)(Q + (size_t)row * DA + col) = pack8(acc[ai][bj][m][0] * QSCALE, acc[ai][bj][m][1] * QSCALE); }
                } else if (pn < 6) {
                    const bool isk = pn < 4; bf16_t* W = isk ? K : V;
                    float* op = out + (row < MP ? (isk ? O_KP : O_VP) + (size_t)row * DA : (isk ? O_KS : O_VS) + (size_t)(row - MP) * DA);
#pragma unroll
                    for (int bj = 0; bj < 2; ++bj) { const int col = (pn & 1) * 256 + bj * HALF + cw;
                        *(u32x4*)(W + (size_t)row * DA + col) = pack8(acc[ai][bj][m][0], acc[ai][bj][m][1]);
                        st_nt(op + col, acc[ai][bj][m][0]); st_nt(op + col + 4, acc[ai][bj][m][1]); }
                } else if (pn < 10) {
                    const int col = (pn - 6) * HALF + cw;
                    const f32x4 u0 = acc[ai][0][m][0] * acc[ai][1][m][0], u1 = acc[ai][0][m][1] * acc[ai][1][m][1];
                    *(u32x4*)(U + (size_t)row * DA + col) = pack8(u0, u1);
                    if (row < MP) { const int t = row & 2047; if (t >= 2046) { float* op = out + O_CP + (size_t)((row >> 11) * 2 + (t - 2046)) * 512 + col; *(f32x4*)op = u0; *(f32x4*)(op + 4) = u1; } }
                    else { const int rr = row - MP, i = rr & 3; if (i >= 2) { float* op = out + O_CS + (size_t)((rr >> 2) * 2 + (i - 2)) * 512 + col; *(f32x4*)op = u0; *(f32x4*)(op + 4) = u1; } }
                } else {
#pragma unroll
                    for (int bj = 0; bj < 2; ++bj) { const int col = (pn - 10) * 256 + bj * HALF + cw;
                        *(u32x4*)(B + (size_t)row * DA + col) = pack8(acc[ai][bj][m][0], acc[ai][bj][m][1]); }
                }
            }
    }
    __device__ __forceinline__ void thin(int row, int pn, int cw, const f32x4 v0, const f32x4 v1) const {
        if (pn < 2) { bf16_t* p = Q + (size_t)row * DA + pn * 256 + cw; *(u32x2*)p = pack4(v0 * QSCALE); *(u32x2*)(p + HALF) = pack4(v1 * QSCALE); }
        else if (pn < 6) { const bool isk = pn < 4; bf16_t* p = (isk ? K : V) + (size_t)row * DA + (pn & 1) * 256 + cw; *(u32x2*)p = pack4(v0); *(u32x2*)(p + HALF) = pack4(v1);
            float* op = out + (isk ? O_KS : O_VS) + (size_t)(row - MP) * DA + (pn & 1) * 256 + cw; *(f32x4*)op = v0; *(f32x4*)(op + HALF) = v1; }
        else if (pn < 10) { const int col = (pn - 6) * HALF + cw; const f32x4 uu = v0 * v1; *(u32x2*)(U + (size_t)row * DA + col) = pack4(uu);
            const int rr = row - MP, i = rr & 3; if (i >= 2) *(f32x4*)(out + O_CS + (size_t)((rr >> 2) * 2 + (i - 2)) * 512 + col) = uu; }
        else { bf16_t* p = B + (size_t)row * DA + (pn - 10) * 256 + cw; *(u32x2*)p = pack4(v0); *(u32x2*)(p + HALF) = pack4(v1); }
    }
};

#define PG8_RLX_AGENT2 __ATOMIC_RELAXED, __HIP_MEMORY_SCOPE_AGENT
__device__ __forceinline__ unsigned long long ssq_word(float sq) { return ((unsigned long long)(sq * 4294967296.0f) << 8) | 1ull; }
__device__ __forceinline__ float ssq_value(unsigned long long w) { return (float)(w >> 8) * (1.0f / 4294967296.0f); }
struct EpiOut {
    static constexpr bool PERM = true, AFTER_DRAIN = false, PREFETCH = false; struct Pre {};
    const float* xp; const float* xs; float* out; bf16_t* HG; const float* g; unsigned long long* ss;
    __device__ __forceinline__ void operator()(const f32x4 (&acc)[2][2][4][2], const Unit& u, int wr, int wc, int fr, int fq) const {
        const int row0 = u.pm * BM + wr * 64 + fr, colb = u.pn * 256 + wc * 32 + 8 * fq;
        f32x4 gv[2][2];
#pragma unroll
        for (int bj = 0; bj < 2; ++bj)
#pragma unroll
            for (int n = 0; n < 2; ++n) gv[bj][n] = *(const f32x4*)(g + colb + bj * HALF + 4 * n);
#pragma unroll
        for (int ai = 0; ai < 2; ++ai)
#pragma unroll
            for (int m = 0; m < 4; ++m) {
                const int row = row0 + ai * HALF + m * 16; const bool ok = row < MV;
                float sq = 0.f;
                if (ok) {
                    const float* xr = row < MP ? xp + (size_t)row * DM : xs + (size_t)(row - MP) * DM;
                    bf16_t* hrow = HG + (size_t)row * DM;
#pragma unroll
                    for (int bj = 0; bj < 2; ++bj) { const int col = colb + bj * HALF;
                        const f32x4 h0 = ld_nt(xr + col) + acc[ai][bj][m][0], h1 = ld_nt(xr + col + 4) + acc[ai][bj][m][1];
                        sq += dot4(h0) + dot4(h1);
                        *(u32x4*)(hrow + col) = pack8(h0 * gv[bj][0], h1 * gv[bj][1]); }
                }
                sq += __shfl_xor(sq, 16); sq += __shfl_xor(sq, 32);
                if (ok && fq == 0) (void)__hip_atomic_fetch_add(ss + row, ssq_word(sq), PG8_RLX_AGENT2);
            }
    }
    __device__ __forceinline__ void thin(int row, int pn, int cw, const f32x4 v0, const f32x4 v1) const {
        const int col = pn * 256 + cw; const float* xr = xs + (size_t)(row - MP) * DM + col; bf16_t* hrow = HG + (size_t)row * DM + col;
        const f32x4 h0 = *(const f32x4*)xr + v0, h1 = *(const f32x4*)(xr + HALF) + v1;
        *(u32x2*)hrow = pack4(h0 * *(const f32x4*)(g + col)); *(u32x2*)(hrow + HALF) = pack4(h1 * *(const f32x4*)(g + col + HALF));
        (void)__hip_atomic_fetch_add(ss + row, ssq_word(dot4(h0) + dot4(h1)), PG8_RLX_AGENT2);
    }
};

struct EpiGU {
    static constexpr bool PERM = true, AFTER_DRAIN = false, PREFETCH = true;
    struct Pre { unsigned hi[2][4]; };
    bf16_t* ACT; const unsigned long long* ss;
    __device__ __forceinline__ void prefetch(Pre& p, const Unit& u, int wr, int fr) const {
        const unsigned* w = (const unsigned*)(ss + u.pm * BM + wr * 64 + fr) + 1;
#pragma unroll
        for (int ai = 0; ai < 2; ++ai)
#pragma unroll
            for (int m = 0; m < 4; ++m) p.hi[ai][m] = w[2 * (ai * HALF + m * 16)];
    }
    __device__ __forceinline__ void operator()(const f32x4 (&acc)[2][2][4][2], const Unit& u, int wr, int wc, int fr, int fq, const Pre& p) const {
        const int row0 = u.pm * BM + wr * 64 + fr, col = u.pn * HALF + wc * 32 + 8 * fq;
#pragma unroll
        for (int ai = 0; ai < 2; ++ai)
#pragma unroll
            for (int m = 0; m < 4; ++m) {
                const int row = row0 + ai * HALF + m * 16;
                const float rs = __builtin_amdgcn_rsqf((float)p.hi[ai][m] * (1.0f / (256.0f * DM)) + RMS_EPS), rs2 = rs * rs, ce = -rs * LOG2E;
                f32x4 o[2];
#pragma unroll
                for (int n = 0; n < 2; ++n) {
                    const f32x4 gu = acc[ai][0][m][n] * acc[ai][1][m][n] * rs2, ex = acc[ai][0][m][n] * ce;
                    f32x4 ev, rv;
#pragma unroll
                    for (int e = 0; e < 4; ++e) ev[e] = __builtin_amdgcn_exp2f(ex[e]);
                    const f32x4 den = ev + 1.0f;
#pragma unroll
                    for (int e = 0; e < 4; ++e) rv[e] = __builtin_amdgcn_rcpf(den[e]);
                    o[n] = gu * rv; }
                *(u32x4*)(ACT + (size_t)row * DFF + col) = pack8(o[0], o[1]);
            }
    }
    __device__ __forceinline__ void thin(int row, int pn, int cw, const f32x4 v0, const f32x4 v1) const {
        const float rs = 1.0f / sqrtf(ssq_value(ss[row]) * (1.0f / DM) + RMS_EPS); f32x4 o;
#pragma unroll
        for (int e = 0; e < 4; ++e) { const float gt = v0[e] * rs, up = v1[e] * rs; o[e] = gt * __builtin_amdgcn_rcpf(1.0f + __builtin_amdgcn_exp2f(-gt * LOG2E)) * up; }
        *(u32x2*)(ACT + (size_t)row * DFF + pn * HALF + cw) = pack4(o);
    }
};

__device__ __forceinline__ f32x4 bf4_to_f32(const u32x2 w) { f32x4 r; r[0] = __builtin_bit_cast(float, w.x << 16); r[1] = __builtin_bit_cast(float, w.x & 0xffff0000u); r[2] = __builtin_bit_cast(float, w.y << 16); r[3] = __builtin_bit_cast(float, w.y & 0xffff0000u); return r; }
#define PG8_RLX_AGENT __ATOMIC_RELAXED, __HIP_MEMORY_SCOPE_AGENT
struct EpiDown {
    static constexpr bool PERM = true, AFTER_DRAIN = false, PREFETCH = false; struct Pre {};
    float* out; unsigned long long* ss; const bf16_t* HG; const float* g; const float* gfin;
    __device__ __forceinline__ void operator()(f32x4 (&acc)[2][2][4][2], const Unit& u, int wr, int wc, int fr, int fq) const {
        const int row0 = u.pm * BM + wr * 64 + fr, colb = u.pn * 256 + wc * 32 + 8 * fq;
        {
            f32x4 gi[2][2];
#pragma unroll
            for (int bj = 0; bj < 2; ++bj)
#pragma unroll
                for (int n = 0; n < 2; ++n) { const f32x4 gg = *(const f32x4*)(g + colb + bj * HALF + 4 * n);
#pragma unroll
                    for (int e = 0; e < 4; ++e) gi[bj][n][e] = __builtin_amdgcn_rcpf(gg[e]); }
#pragma unroll
            for (int ai = 0; ai < 2; ++ai)
#pragma unroll
                for (int m = 0; m < 4; ++m) {
                    const int row = row0 + ai * HALF + m * 16; const bf16_t* hrow = HG + (size_t)row * DM;
                    float sq = 0.f;
#pragma unroll
                    for (int bj = 0; bj < 2; ++bj) { const int col = colb + bj * HALF; const u32x4 hw = *(const u32x4*)(hrow + col);
                        const f32x4 h0 = bf4_to_f32((u32x2){hw.x, hw.y}) * gi[bj][0] + acc[ai][bj][m][0], h1 = bf4_to_f32((u32x2){hw.z, hw.w}) * gi[bj][1] + acc[ai][bj][m][1];
                        acc[ai][bj][m][0] = h0; acc[ai][bj][m][1] = h1; sq += dot4(h0) + dot4(h1); }
                    sq += __shfl_xor(sq, 16); sq += __shfl_xor(sq, 32);
                    if (fq == 0) (void)__hip_atomic_fetch_add(ss + row, ssq_word(sq), PG8_RLX_AGENT);
                }
        }
        f32x4 gf[2][2];
#pragma unroll
        for (int bj = 0; bj < 2; ++bj)
#pragma unroll
            for (int n = 0; n < 2; ++n) gf[bj][n] = *(const f32x4*)(gfin + colb + bj * HALF + 4 * n);
        unsigned long long tw[2][4];
        for (unsigned sp = 0u;; ++sp) {
            bool done = true;
#pragma unroll
            for (int ai = 0; ai < 2; ++ai)
#pragma unroll
                for (int m = 0; m < 4; ++m) { tw[ai][m] = __hip_atomic_load(ss + row0 + ai * HALF + m * 16, PG8_RLX_AGENT); done = done && ((unsigned)tw[ai][m] & 255u) >= 16u; }
            if (!__any(!done) || sp > (1u << 20)) break;
            __builtin_amdgcn_s_sleep(2);
        }
#pragma unroll
        for (int ai = 0; ai < 2; ++ai)
#pragma unroll
            for (int m = 0; m < 4; ++m) {
                const int row = row0 + ai * HALF + m * 16; float* orow = out + (size_t)row * DM;
                const float rs = 1.0f / sqrtf(ssq_value(tw[ai][m]) * (1.0f / DM) + RMS_EPS);
#pragma unroll
                for (int bj = 0; bj < 2; ++bj) { const int col = colb + bj * HALF;
                    st_nt(orow + col, acc[ai][bj][m][0] * rs * gf[bj][0]); st_nt(orow + col + 4, acc[ai][bj][m][1] * rs * gf[bj][1]); }
            }
    }
    __device__ __forceinline__ void thin(int row, int pn, int cw, const f32x4 v0, const f32x4 v1) const {
        const int col = pn * 256 + cw; float* orow = out + (size_t)row * DM + col; const bf16_t* hrow = HG + (size_t)row * DM + col;
        const f32x4 g0 = *(const f32x4*)(g + col), g1 = *(const f32x4*)(g + col + HALF);
        const f32x4 h0 = bf4_to_f32(*(const u32x2*)hrow) / g0 + v0, h1 = bf4_to_f32(*(const u32x2*)(hrow + HALF)) / g1 + v1;
        (void)__hip_atomic_fetch_add(ss + row, ssq_word(dot4(h0) + dot4(h1)), PG8_RLX_AGENT);
        const f32x4 f0 = *(const f32x4*)(gfin + col), f1 = *(const f32x4*)(gfin + col + HALF);
        unsigned long long w;
        for (unsigned sp = 0u;; ++sp) { w = __hip_atomic_load(ss + row, PG8_RLX_AGENT); if (!__any(((unsigned)w & 255u) < 128u) || sp > (1u << 20)) break; __builtin_amdgcn_s_sleep(2); }
        const float rs = 1.0f / sqrtf(ssq_value(w) * (1.0f / DM) + RMS_EPS);
        *(f32x4*)orow = h0 * rs * f0; *(f32x4*)(orow + HALF) = h1 * rs * f1;
    }
};
template <class Epi, class Sched, bool ALIGN_EPI = false, bool SP2 = false>
__device__ __forceinline__ void gemm_phase(PG8_LAS unsigned char* lds, const Gemm g, const Sched& S, const Epi& E) {
    int tid_ = threadIdx.x; asm volatile("" : "+v"(tid_));
    const int tid = tid_, wid = __builtin_amdgcn_readfirstlane(tid >> 6), lane = tid & 63, wr = wid >> 2, wc = wid & 3, fr = lane & 15, fq = lane >> 4;
    const int K = g.K, nt = K / BK;
    unsigned voffA[2], voffB[2];
#pragma unroll
    for (int i = 0; i < 2; ++i) { int R, C; stage_rc(tid * 16 + i * 8192, R, C); const int Rb = Epi::PERM ? ((R & ~31) + perm32(R & 31)) : R;
        voffA[i] = (unsigned)(R * K + C) * 2u; voffB[i] = (unsigned)(Rb * K + C) * 2u; }
    const size_t kstep = (size_t)(BK * 2);
    const size_t hstep = (size_t)HALF * K * 2;
    const size_t tstep = 2 * hstep;
    const unsigned ldsw = (unsigned)wid * 1024u;
    const int aoff = lds_byte(wr * 64 + fr, fq * 8), boff = lds_byte(wc * 32 + fr, fq * 8);
#define PG8_SA(b, h) (((b) * 2 + (h)) * HTB)
#define PG8_SB(b, h) ((4 + (b) * 2 + (h)) * HTB)
#define PG8_STAGE(bufoff, gbase, voff) do { _Pragma("unroll") for (int _i = 0; _i < 2; ++_i) \
        __builtin_amdgcn_global_load_lds((const unsigned*)((const char*)(gbase) + (voff)[_i]), (PG8_LAS unsigned*)(lds + (bufoff) + ldsw + _i * 8192), 16, 0, 0); } while (0)
#define PG8_LDA(dst, b, h) do { _Pragma("unroll") for (int m = 0; m < 4; ++m) _Pragma("unroll") for (int k = 0; k < 2; ++k) dst[m][k] = *(const PG8_LAS bf16x8*)(lds + PG8_SA(b, h) + aoff + m * 2048 + k * 1024); } while (0)
#define PG8_LDB(dst, b, h) do { _Pragma("unroll") for (int n = 0; n < 2; ++n) _Pragma("unroll") for (int k = 0; k < 2; ++k) dst[n][k] = *(const PG8_LAS bf16x8*)(lds + PG8_SB(b, h) + boff + n * 2048 + k * 1024); } while (0)
#define PG8_MMA(ai, bj, At, Bt) do { __builtin_amdgcn_s_setprio(1); _Pragma("unroll") for (int m = 0; m < 4; ++m) _Pragma("unroll") for (int n = 0; n < 2; ++n) _Pragma("unroll") for (int k = 0; k < 2; ++k) \
        acc[ai][bj][m][n] = __builtin_amdgcn_mfma_f32_16x16x32_bf16(Bt[n][k], At[m][k], acc[ai][bj][m][n], 0, 0, 0); __builtin_amdgcn_s_setprio(0); } while (0)
#define PG8_WAIT_V(n) asm volatile("s_waitcnt vmcnt(" #n ")" ::: "memory")
#define PG8_WAIT_L(n) asm volatile("s_waitcnt lgkmcnt(" #n ")" ::: "memory")
#define PG8_BAR __builtin_amdgcn_s_barrier()
#define PG8_SCHED __builtin_amdgcn_sched_barrier(0)
    Unit cur, nxt; int ui = 0;
    if (!S.next(0, cur)) return;
    f32x4 acc[2][2][4][2];
    typename Epi::Pre pre_{};
#pragma unroll
    for (int a = 0; a < 2; ++a)
#pragma unroll
        for (int b = 0; b < 2; ++b)
#pragma unroll
            for (int m = 0; m < 4; ++m)
#pragma unroll
                for (int n = 0; n < 2; ++n) acc[a][b][m][n] = (f32x4){0.f, 0.f, 0.f, 0.f};
    bf16x8 At[4][2], B0[2][2], B1[2][2];
    const char* cA = (const char*)g.A + (size_t)cur.pm * tstep; const char* cB = (const char*)g.Bt + (size_t)cur.pn * tstep;
    S.a_ready(cur);
    if constexpr (SP2) {
        PG8_STAGE(PG8_SB(0, 0), cB, voffB); PG8_STAGE(PG8_SB(0, 1), cB + hstep, voffB); PG8_STAGE(PG8_SA(0, 0), cA, voffA); PG8_STAGE(PG8_SA(0, 1), cA + hstep, voffA);
        if (wr == 1) PG8_BAR;
        PG8_WAIT_V(2); PG8_BAR;
        PG8_STAGE(PG8_SB(1, 0), cB + kstep, voffB); PG8_STAGE(PG8_SA(1, 0), cA + kstep, voffA); PG8_STAGE(PG8_SB(1, 1), cB + hstep + kstep, voffB);
        PG8_WAIT_V(6); PG8_BAR;
    } else {
        PG8_STAGE(PG8_SB(0, 0), cB, voffB); PG8_STAGE(PG8_SA(0, 0), cA, voffA); PG8_STAGE(PG8_SB(0, 1), cB + hstep, voffB); PG8_STAGE(PG8_SA(0, 1), cA + hstep, voffA);
        if (wr == 1) PG8_BAR;
        PG8_WAIT_V(4); PG8_BAR;
        PG8_STAGE(PG8_SB(1, 0), cB + kstep, voffB); PG8_STAGE(PG8_SA(1, 0), cA + kstep, voffA); PG8_STAGE(PG8_SB(1, 1), cB + hstep + kstep, voffB);
        PG8_WAIT_V(6); PG8_BAR;
    }
    for (;;) {
        const bool has_next = S.next(ui + 1, nxt);
        const char* nA = has_next ? (const char*)g.A + (size_t)nxt.pm * tstep : cA; const char* nB = has_next ? (const char*)g.Bt + (size_t)nxt.pn * tstep : cB;
        for (int t = 0; t < nt; t += 2) {
            const bool last = (t == nt - 2);
            const char* a1 = cA + (size_t)(t + 1) * kstep;
            const char* a2 = last ? nA : cA + (size_t)(t + 2) * kstep; const char* b2 = last ? nB : cB + (size_t)(t + 2) * kstep;
            const char* a3 = a2 + kstep; const char* b3 = b2 + kstep;
            if (last && has_next) S.a_ready(nxt);
            if constexpr (Epi::PREFETCH) { if (last) E.prefetch(pre_, cur, wr, fr); }
            if constexpr (SP2) {
            PG8_LDB(B0, 0, 0); PG8_LDB(B1, 0, 1); PG8_SCHED; PG8_LDA(At, 0, 0); PG8_STAGE(PG8_SA(1, 1), a1 + hstep, voffA);
            PG8_WAIT_V(8); PG8_WAIT_L(0); PG8_BAR; PG8_MMA(0, 0, At, B0); PG8_MMA(0, 1, At, B1); PG8_BAR; PG8_SCHED;
            PG8_LDA(At, 0, 1); PG8_STAGE(PG8_SB(0, 0), b2, voffB); PG8_STAGE(PG8_SB(0, 1), b2 + hstep, voffB); PG8_STAGE(PG8_SA(0, 0), a2, voffA);
            PG8_WAIT_V(8); PG8_WAIT_L(0); PG8_BAR; PG8_MMA(1, 0, At, B0); PG8_MMA(1, 1, At, B1); PG8_BAR; PG8_SCHED;
            PG8_LDB(B0, 1, 0); PG8_LDB(B1, 1, 1); PG8_SCHED; PG8_LDA(At, 1, 0); PG8_STAGE(PG8_SA(0, 1), a2 + hstep, voffA);
            PG8_WAIT_V(8); PG8_WAIT_L(0); PG8_BAR; PG8_MMA(0, 0, At, B0); PG8_MMA(0, 1, At, B1); PG8_BAR; PG8_SCHED;
            PG8_LDA(At, 1, 1); PG8_STAGE(PG8_SB(1, 0), b3, voffB); PG8_STAGE(PG8_SB(1, 1), b3 + hstep, voffB); PG8_STAGE(PG8_SA(1, 0), a3, voffA);
            PG8_WAIT_V(8); PG8_WAIT_L(0); PG8_BAR; PG8_MMA(1, 0, At, B0); PG8_MMA(1, 1, At, B1); PG8_BAR; PG8_SCHED;
            } else {
            PG8_LDB(B0, 0, 0); PG8_SCHED; PG8_LDA(At, 0, 0); PG8_STAGE(PG8_SA(1, 1), a1 + hstep, voffA);
            PG8_WAIT_L(8); PG8_BAR; PG8_WAIT_L(0); PG8_MMA(0, 0, At, B0); PG8_BAR; PG8_SCHED;
            PG8_LDB(B1, 0, 1); PG8_STAGE(PG8_SB(0, 0), b2, voffB);
            PG8_BAR; PG8_WAIT_L(0); PG8_MMA(0, 1, At, B1); PG8_BAR;
            PG8_LDA(At, 0, 1); PG8_STAGE(PG8_SA(0, 0), a2, voffA);
            PG8_BAR; PG8_WAIT_L(0); PG8_MMA(1, 0, At, B0); PG8_BAR; PG8_SCHED;
            PG8_STAGE(PG8_SB(0, 1), b2 + hstep, voffB);
            PG8_WAIT_V(6); PG8_BAR; PG8_MMA(1, 1, At, B1); PG8_BAR;
            PG8_LDB(B0, 1, 0); PG8_SCHED; PG8_LDA(At, 1, 0); PG8_STAGE(PG8_SA(0, 1), a2 + hstep, voffA);
            PG8_WAIT_L(8); PG8_BAR; PG8_WAIT_L(0); PG8_MMA(0, 0, At, B0); PG8_BAR; PG8_SCHED;
            PG8_LDB(B1, 1, 1); PG8_STAGE(PG8_SB(1, 0), b3, voffB);
            PG8_BAR; PG8_WAIT_L(0); PG8_MMA(0, 1, At, B1); PG8_BAR;
            PG8_LDA(At, 1, 1); PG8_STAGE(PG8_SA(1, 0), a3, voffA);
            PG8_BAR; PG8_WAIT_L(0); PG8_MMA(1, 0, At, B0); PG8_BAR; PG8_SCHED;
            PG8_STAGE(PG8_SB(1, 1), b3 + hstep, voffB);
            PG8_WAIT_V(6); PG8_BAR; PG8_MMA(1, 1, At, B1); PG8_BAR;
            }
        }
        if constexpr (ALIGN_EPI) { if (wr == 0) PG8_BAR; }
        if constexpr (!Epi::AFTER_DRAIN) { if constexpr (Epi::PREFETCH) E(acc, cur, wr, wc, fr, fq, pre_); else E(acc, cur, wr, wc, fr, fq); S.done(cur); }
        if (!has_next) break;
#pragma unroll
        for (int a = 0; a < 2; ++a)
#pragma unroll
            for (int b = 0; b < 2; ++b)
#pragma unroll
                for (int m = 0; m < 4; ++m)
#pragma unroll
                    for (int n = 0; n < 2; ++n) acc[a][b][m][n] = (f32x4){0.f, 0.f, 0.f, 0.f};
        cur = nxt; cA = nA; cB = nB; ++ui;
        if constexpr (ALIGN_EPI) { if (wr == 1) PG8_BAR; }
    }
    PG8_WAIT_V(0);
    if constexpr (!ALIGN_EPI) { if (wr == 0) PG8_BAR; }
    PG8_BAR;
    if constexpr (Epi::AFTER_DRAIN) { E.fused(acc, cur, wr, wc, fr, fq, lds, wid, lane); S.done(cur); }
#undef PG8_SA
#undef PG8_SB
#undef PG8_STAGE
#undef PG8_LDA
#undef PG8_LDB
#undef PG8_MMA
#undef PG8_WAIT_V
#undef PG8_WAIT_L
#undef PG8_BAR
#undef PG8_SCHED
}
}

constexpr size_t MiB = 1u << 20;
constexpr size_t WS_SS1 = 0  , WS_SS2 = 264 * 1024  , WS_BAR = 640 * 1024  , WS_CTL_BYTES = 704 * 1024;
constexpr size_t WS_WIN = 1 * MiB, WS_WOUT = 7 * MiB, WS_WGU = 9 * MiB, WS_WDN = 20 * MiB;
constexpr size_t WS_XN = 26 * MiB;
constexpr size_t WS_Q = 91 * MiB, WS_K = 124 * MiB, WS_V = 157 * MiB, WS_U = 190 * MiB, WS_B = 223 * MiB;
constexpr size_t WS_MIX = 256 * MiB;
constexpr size_t WS_ACT = 91 * MiB;
constexpr size_t WS_END = 321 * MiB;
static_assert(WS_SS1 + (size_t)MT * 8 <= WS_SS2 && WS_SS2 + (size_t)MT * 8 <= WS_BAR, "control map");
static_assert(WS_XN + (size_t)MT * DM * 2 <= WS_Q && WS_Q + (size_t)MT * DA * 2 <= WS_K && WS_MIX + (size_t)MT * DM * 2 <= WS_END && WS_ACT + (size_t)MT * DFF * 2 <= WS_END, "ws map");

constexpr int LDS_BYTES = 147456;
#define LAS __attribute__((address_space(3)))
typedef unsigned short bf16;
typedef short bf16x8 __attribute__((ext_vector_type(8)));
typedef float f32x4 __attribute__((ext_vector_type(4)));
typedef float f32x2 __attribute__((ext_vector_type(2)));
typedef float f32x16 __attribute__((ext_vector_type(16)));
typedef unsigned u32x4 __attribute__((ext_vector_type(4)));
typedef unsigned u32x2 __attribute__((ext_vector_type(2)));

__device__ __forceinline__ unsigned f2bf(float f) { unsigned u = __builtin_bit_cast(unsigned, f); return (u + 0x7fffu + ((u >> 16) & 1u)) >> 16; }
__device__ __forceinline__ unsigned pk2(float lo, float hi) { return f2bf(lo) | (f2bf(hi) << 16); }
typedef __bf16 bf16x2_t __attribute__((ext_vector_type(2)));
__device__ __forceinline__ unsigned cvtpk(float lo, float hi) { f32x2 v = {lo, hi}; bf16x2_t b = __builtin_convertvector(v, bf16x2_t); return __builtin_bit_cast(unsigned, b); }
__device__ __forceinline__ float bf2f(unsigned short x) { return __builtin_bit_cast(float, (unsigned)x << 16); }
__device__ __forceinline__ float bflo(unsigned w) { return __builtin_bit_cast(float, w << 16); }
__device__ __forceinline__ float bfhi(unsigned w) { return __builtin_bit_cast(float, w & 0xffff0000u); }
__device__ __forceinline__ float wave_sum(float v) {
#pragma unroll
    for (int o = 1; o < 64; o <<= 1) v += __shfl_xor(v, o);
    return v;
}
__device__ __forceinline__ float wave_max(float v) {
#pragma unroll
    for (int o = 1; o < 64; o <<= 1) v = fmaxf(v, __shfl_xor(v, o));
    return v;
}
#define LDS_FENCE() asm volatile("s_waitcnt lgkmcnt(0)" ::: "memory")

#define XB_TMO      128
#define XB_XCNT(j)  (256  + 64 * (j))
#define XB_XSUB(j)  (1280 + 64 * (j))
#define XB_XGEN(j)  (2304 + 64 * (j))
#define XB_TOP      3328
#define XB_TOPGEN   3392
#define XCD_BAR_WORDS 3456
#define XB_SPIN_CAP (1u << 18)

__device__ __forceinline__ unsigned xb_ld(unsigned* p)              { return __hip_atomic_load(p, __ATOMIC_RELAXED, __HIP_MEMORY_SCOPE_AGENT); }
__device__ __forceinline__ unsigned xb_add(unsigned* p, unsigned v) { return __hip_atomic_fetch_add(p, v, __ATOMIC_RELAXED, __HIP_MEMORY_SCOPE_AGENT); }
__device__ __forceinline__ unsigned xb_xcc_id() { return (unsigned)__builtin_amdgcn_s_getreg((3 << 11) | 20) & 0xFu; }
#define XB_SPIN(cond, bar) do { unsigned _sp = 0; while (cond) { __builtin_amdgcn_s_sleep(1); \
    if ((++_sp & 255u) == 0u) { if (xb_ld(&(bar)[XB_TMO])) break; if (_sp > XB_SPIN_CAP) { atomicAdd(&(bar)[XB_TMO], 1u); break; } } } } while (0)

struct XcdBarrier {
    unsigned* bar; unsigned x;
    volatile LAS unsigned* st;
};

__device__ __forceinline__ XcdBarrier xcd_barrier_post(unsigned* bar, volatile LAS unsigned* st) {
    XcdBarrier b; b.bar = bar; b.x = xb_xcc_id(); b.st = st;
    if (threadIdx.x == 0) (void)xb_add(&bar[XB_XCNT(b.x)], 1u);
    return b;
}
__device__ __forceinline__ void xcd_barrier_complete(unsigned* bar, unsigned x, unsigned& nloc, unsigned& nx) {
    const unsigned G = gridDim.x * gridDim.y * gridDim.z;
    unsigned sum, cnt, mine, sp = 0u;
    for (;;) {
        sum = 0u; cnt = 0u; mine = 0u;
#pragma unroll
        for (unsigned j = 0; j < 16; ++j) { const unsigned c = xb_ld(&bar[XB_XCNT(j)]); sum += c; cnt += (c > 0u) ? 1u : 0u; mine = (j == x) ? c : mine; }
        if (sum == G) break;
        __builtin_amdgcn_s_sleep(1);
        if ((++sp & 255u) == 0u) { if (xb_ld(&bar[XB_TMO])) break; if (sp > XB_SPIN_CAP) { atomicAdd(&bar[XB_TMO], 1u); break; } }
    }
    nloc = mine > 0u ? mine : 1u; nx = cnt > 0u ? cnt : 1u;
}

__device__ __forceinline__ void xcd_barrier(const XcdBarrier& b) {
    asm volatile("s_waitcnt vmcnt(0)" ::: "memory");
    __syncthreads();
    if (threadIdx.x == 0) {
        unsigned* bar = b.bar;
        __builtin_amdgcn_s_waitcnt(0);
        unsigned nloc = b.st[0], nx = b.st[1];
        if (nloc == 0u) { xcd_barrier_complete(bar, b.x, nloc, nx); b.st[0] = nloc; b.st[1] = nx; }
        const unsigned old = xb_add(&bar[XB_XSUB(b.x)], 1u);
        const unsigned gen = old / nloc;
        if (old + 1u == (gen + 1u) * nloc) {
            __builtin_amdgcn_fence(__ATOMIC_RELEASE, "agent");
            asm volatile("s_waitcnt vmcnt(0)" ::: "memory");
            const unsigned og = xb_add(&bar[XB_TOP], 1u);
            const unsigned tg = og / nx;
            if (og + 1u == (tg + 1u) * nx) xb_add(&bar[XB_TOPGEN], 1u);
            else XB_SPIN(xb_ld(&bar[XB_TOPGEN]) == tg, bar);
            __builtin_amdgcn_fence(__ATOMIC_ACQUIRE, "agent");
            xb_add(&bar[XB_XGEN(b.x)], 1u);
            asm volatile("s_waitcnt vmcnt(0)" ::: "memory");
        } else {
            XB_SPIN(xb_ld(&bar[XB_XGEN(b.x)]) == gen, bar);
            __builtin_amdgcn_fence(__ATOMIC_ACQUIRE, "agent");
            asm volatile("s_waitcnt vmcnt(0)" ::: "memory");
        }
    }
    __syncthreads();
}

__device__ __forceinline__ void transpose_item(const float* W, int ldw, int K, bf16* WT, int drow0, int scol0, int kb, LAS float* scr, int lane) {
    const int k0 = 64 * kb;
#pragma unroll
    for (int i = 0; i < 32; ++i) { const int kk = 2 * i + (lane >> 5); scr[kk * 33 + (lane & 31)] = __builtin_nontemporal_load(W + (size_t)(k0 + kk) * ldw + scol0 + (lane & 31)); }
    LDS_FENCE();
    const int c = lane & 7;
#pragma unroll
    for (int j = 0; j < 4; ++j) { const int n = (lane >> 3) + 8 * j; const LAS float* s = scr + (8 * c) * 33 + n;
        u32x4 o; o.x = pk2(s[0 * 33], s[1 * 33]); o.y = pk2(s[2 * 33], s[3 * 33]); o.z = pk2(s[4 * 33], s[5 * 33]); o.w = pk2(s[6 * 33], s[7 * 33]);
        *(u32x4*)(WT + (size_t)(drow0 + n) * K + k0 + 8 * c) = o; }
    LDS_FENCE();
}
__device__ __forceinline__ void rms_rows2_to_bf16(const float* xrow0, const float* xrow1, const float* g, bf16* orow0, bf16* orow1, int lane) {
    const f32x4* gr = (const f32x4*)g + lane;
    f32x4 v[2][4]; float s[2] = {0.f, 0.f};
#pragma unroll
    for (int k = 0; k < 2; ++k) { const float* xr_ = k ? xrow1 : xrow0; if (xr_) { const f32x4* xr = (const f32x4*)xr_ + lane;
#pragma unroll
        for (int j = 0; j < 4; ++j) v[k][j] = __builtin_nontemporal_load(xr + 64 * j); } }
#pragma unroll
    for (int k = 0; k < 2; ++k) { if (k ? xrow1 != nullptr : true) {
#pragma unroll
        for (int j = 0; j < 4; ++j) s[k] += (v[k][j].x * v[k][j].x + v[k][j].y * v[k][j].y) + (v[k][j].z * v[k][j].z + v[k][j].w * v[k][j].w); } }
#pragma unroll
    for (int k = 0; k < 2; ++k) { bf16* orow = k ? orow1 : orow0; if (k && !xrow1) continue;
        const float rs = 1.0f / sqrtf(wave_sum(s[k]) * (1.0f / DM) + RMS_EPS);
        unsigned long long* o8 = (unsigned long long*)orow + lane;
#pragma unroll
        for (int j = 0; j < 4; ++j) { const f32x4 gg = gr[64 * j];
            o8[64 * j] = (unsigned long long)cvtpk(v[k][j].x * rs * gg.x, v[k][j].y * rs * gg.y) | ((unsigned long long)cvtpk(v[k][j].z * rs * gg.z, v[k][j].w * rs * gg.w) << 32); } }
}

constexpr int AT_PO = 0, AT_ML = 65536, AT_VST = 69632, AT_VST_W = 9216;
__device__ __forceinline__ int po_off(int slot, int g4) { return slot * 128 + (((g4 ^ (slot ^ (slot >> 4))) & 15) << 3); }

typedef short s16x4 __attribute__((ext_vector_type(4)));
__device__ __forceinline__ s16x4 vtr(const LAS unsigned short* p) { return __builtin_bit_cast(s16x4, __builtin_amdgcn_ds_read_tr16_b64_v4i16((LAS s16x4*)p)); }
struct AtP { const bf16* Qh; const bf16* Kh; const bf16* Vh; bf16* Oh; float sl2; int st, d, c, eq0, slot0, sstride; };
__device__ __forceinline__ AtP at_params(int g, int vcu, int G, int wave, const bf16* Q, const bf16* K, const bf16* V, bf16* MIX) {
    const int ui = g / 6, n = g - 6 * ui, u = vcu + ui * G, b = u >> 5, h = (u >> 2) & 7, blk = (ui & 1) ? 3 - (u & 3) : (u & 3)  , st = n >> 1, tau = wave + 8 * (n & 1);
    const size_t rb = (size_t)b * 2048;
    AtP p; p.Qh = Q + rb * DA + h * 64; p.Kh = K + rb * DA + h * 64; p.Vh = V + rb * DA + h * 64; p.Oh = MIX + (rb + 512 * blk) * DM + h * 64;
    p.sl2 = __builtin_amdgcn_exp2f(-(float)(h + 1)) * LOG2E; p.st = st;
    if (st == 0)      { p.d = 16; p.c = tau;     p.eq0 = 32 * blk;                    p.slot0 = tau;                          p.sstride = 16; }
    else if (st == 1) { p.d = 4;  p.c = tau & 3; p.eq0 = 128 * blk + 32 * (tau >> 2); p.slot0 = (tau & 3) + 128 * (tau >> 2); p.sstride = 4; }
    else              { p.d = 1;  p.c = 0;       p.eq0 = 512 * blk + 32 * tau;        p.slot0 = 32 * tau;                     p.sstride = 1; }
    return p;
}
__device__ __forceinline__ void attn_prompt_all(LAS unsigned char* lds, int vcu, int G, const bf16* Q, const bf16* K, const bf16* V, bf16* MIX) {
    const int tid = threadIdx.x, lane = tid & 63, wave = __builtin_amdgcn_readfirstlane(tid >> 6), r32 = lane & 31, hi = lane >> 5;
    LAS unsigned short* vs = (LAS unsigned short*)(lds + AT_VST + wave * AT_VST_W);
    LAS unsigned short* ks = vs + 2304;
    LAS f32x2* ML = (LAS f32x2*)(lds + AT_ML);
    const int nunits = (512 - vcu + G - 1) / G, T = 6 * nunits;
    const int th = r32 - 4 * hi;
    bf16x8 qn[4]; u32x4 kn[4], vn[4];
#define AT_LOADQ(P) do { const bf16* qp_ = (P).Qh + (size_t)((P).c + (P).d * ((P).eq0 + r32)) * DA + 8 * hi; \
        _Pragma("unroll") for (int d0 = 0; d0 < 4; ++d0) qn[d0] = *(const bf16x8*)(qp_ + 16 * d0); } while (0)
#define AT_LOAD(P, kt) do { const int e0_ = (P).eq0 - 128 + 32 * (kt); \
        _Pragma("unroll") for (int j = 0; j < 4; ++j) { const size_t ro_ = (size_t)((P).c + (P).d * (e0_ + (lane >> 3) + 8 * j)) * DA + 8 * (lane & 7); \
            kn[j] = *(const u32x4*)((P).Kh + ro_); vn[j] = *(const u32x4*)((P).Vh + ro_); } } while (0)
    AtP nx = at_params(0, vcu, G, wave, Q, K, V, MIX);
    if (T > 0) { AT_LOADQ(nx); AT_LOAD(nx, 4); }
#pragma unroll 1
    for (int g = 0; g < T; ++g) {
        const AtP p = nx;
        bf16x8 qf[4];
#pragma unroll
        for (int d0 = 0; d0 < 4; ++d0) qf[d0] = qn[d0];
        const bool have_next = g + 1 < T;
        if (have_next) { nx = at_params(g + 1, vcu, G, wave, Q, K, V, MIX); AT_LOADQ(nx); }
        float m = -4096.0f, l = 0.f; f32x16 o0, o1;
#pragma unroll
        for (int r = 0; r < 16; ++r) { o0[r] = 0.f; o1[r] = 0.f; }
        int kt0 = (128 - p.eq0) / 32; if (kt0 < 0) kt0 = 0;
        const float sld = p.sl2 * (float)p.d;
        f32x16 cst;
#pragma unroll
        for (int r = 0; r < 16; ++r) cst[r] = sld * (float)((r & 3) + 8 * (r >> 2));
#pragma unroll 1
        for (int kt = 4; kt >= kt0; --kt) {
            LDS_FENCE();
#pragma unroll
            for (int j = 0; j < 4; ++j) { const int key = (lane >> 3) + 8 * j, vrow = (key & 0x13) | ((key & 4) << 1) | ((key & 8) >> 1);
                *(LAS u32x4*)(vs + vrow * 72 + 8 * (lane & 7)) = vn[j]; *(LAS u32x4*)(ks + key * 72 + 8 * (lane & 7)) = kn[j]; }
            if (kt > kt0) AT_LOAD(p, kt - 1); else if (have_next) AT_LOAD(nx, 4);
            LDS_FENCE();
            bf16x8 kc[4];
#pragma unroll
            for (int d0 = 0; d0 < 4; ++d0) kc[d0] = *(const LAS bf16x8*)(ks + r32 * 72 + 16 * d0 + 8 * hi);
            __builtin_amdgcn_sched_barrier(0);
            const float b0 = -sld * (float)(128 - 32 * kt + th) - m;
            f32x16 s;
#pragma unroll
            for (int r = 0; r < 16; ++r) s[r] = cst[r] + b0;
            __builtin_amdgcn_s_setprio(1);
#pragma unroll
            for (int d0 = 0; d0 < 4; ++d0) s = __builtin_amdgcn_mfma_f32_32x32x16_bf16(kc[d0], qf[d0], s, 0, 0, 0);
            __builtin_amdgcn_s_setprio(0);
            if (kt == 4) {
#pragma unroll
                for (int r = 0; r < 16; ++r) s[r] = ((r & 3) + 8 * (r >> 2) <= th) ? s[r] : -3e38f; }
            if (kt == 0) {
#pragma unroll
                for (int r = 0; r < 16; ++r) s[r] = ((r & 3) + 8 * (r >> 2) >= th) ? s[r] : -3e38f; }
            float mt = s[0];
#pragma unroll
            for (int r = 1; r < 16; ++r) mt = fmaxf(mt, s[r]);
            { auto rr = __builtin_amdgcn_permlane32_swap(__float_as_uint(mt), __float_as_uint(mt), false, false); mt = fmaxf(__uint_as_float(rr[0]), __uint_as_float(rr[1])); }
            if (__any(mt > 0.f)) {
                const float dl = fmaxf(mt, 0.f), alpha = __builtin_amdgcn_exp2f(-dl);
                m += dl; l *= alpha;
#pragma unroll
                for (int r = 0; r < 16; ++r) { s[r] -= dl; o0[r] *= alpha; o1[r] *= alpha; }
            }
            float ls = 0.f;
#pragma unroll
            for (int r = 0; r < 16; ++r) { s[r] = __builtin_amdgcn_exp2f(s[r]); ls += s[r]; }
            l += ls;
            bf16x8 pf[2];
#pragma unroll
            for (int s2 = 0; s2 < 2; ++s2) { u32x4 w; w.x = cvtpk(s[8 * s2 + 0], s[8 * s2 + 1]); w.y = cvtpk(s[8 * s2 + 2], s[8 * s2 + 3]); w.z = cvtpk(s[8 * s2 + 4], s[8 * s2 + 5]); w.w = cvtpk(s[8 * s2 + 6], s[8 * s2 + 7]);
                pf[s2] = __builtin_bit_cast(bf16x8, w); }
#pragma unroll
            for (int s2 = 0; s2 < 2; ++s2) {
                const LAS unsigned short* tb = vs + (16 * s2 + 8 * hi + ((lane & 15) >> 2)) * 72 + 16 * ((lane >> 4) & 1) + 4 * (lane & 3);
                const s16x4 a0 = vtr(tb), a1 = vtr(tb + 4 * 72), b0_ = vtr(tb + 32), b1_ = vtr(tb + 4 * 72 + 32);
                const bf16x8 v0 = __builtin_shufflevector(a0, a1, 0, 1, 2, 3, 4, 5, 6, 7), v1 = __builtin_shufflevector(b0_, b1_, 0, 1, 2, 3, 4, 5, 6, 7);
                __builtin_amdgcn_s_setprio(1);
                o0 = __builtin_amdgcn_mfma_f32_32x32x16_bf16(v0, pf[s2], o0, 0, 0, 0);
                o1 = __builtin_amdgcn_mfma_f32_32x32x16_bf16(v1, pf[s2], o1, 0, 0, 0);
                __builtin_amdgcn_s_setprio(0);
            }
        }
        { auto rr = __builtin_amdgcn_permlane32_swap(__float_as_uint(l), __float_as_uint(l), false, false); l = __uint_as_float(rr[0]) + __uint_as_float(rr[1]); }
        const int slot = p.slot0 + p.sstride * r32, st = p.st;
        float ca, cb;
        if (st == 0) { ca = 1.0f / l; cb = 0.f; if (hi == 0) ML[slot] = (f32x2){m, l}; }
        else { const f32x2 ml = ML[slot]; const float M = fmaxf(m, ml.x), e1 = __builtin_amdgcn_exp2f(m - M), wn = l * e1, wo = ml.y * __builtin_amdgcn_exp2f(ml.x - M), inv = 1.0f / (wn + wo);
            ca = e1 * inv; cb = wo * inv; LDS_FENCE(); if (hi == 0) ML[slot] = (f32x2){M, wn + wo}; }
#pragma unroll
        for (int nh = 0; nh < 2; ++nh)
#pragma unroll
            for (int rg = 0; rg < 4; ++rg) {
                const int g4 = 8 * nh + 2 * rg + hi;
                LAS u32x2* pp = (LAS u32x2*)(lds + AT_PO + po_off(slot, g4));
                float v[4];
#pragma unroll
                for (int e2 = 0; e2 < 4; ++e2) v[e2] = ca * (nh ? o1[4 * rg + e2] : o0[4 * rg + e2]);
                if (st != 0) { const u32x2 old = *pp; v[0] += cb * bflo(old.x); v[1] += cb * bfhi(old.x); v[2] += cb * bflo(old.y); v[3] += cb * bfhi(old.y); }
                u32x2 w; w.x = cvtpk(v[0], v[1]); w.y = cvtpk(v[2], v[3]);
                if (st != 2) *pp = w;
                else *(u32x2*)(p.Oh + (size_t)slot * DM + 4 * g4) = w;
            }
        if (g & 1) asm volatile("s_waitcnt lgkmcnt(0)\n\ts_barrier" ::: "memory");
    }
#undef AT_LOADQ
#undef AT_LOAD
}

__device__ __forceinline__ void attn_sample_bh(LAS unsigned char* lds, int b, int h, const bf16* Q, const float* sk, const float* sv, const float* outp, bf16* MIX) {
    LAS float* qs = (LAS float*)lds;
    LAS float* sb = qs + 256;
    LAS float* lb = sb + 4 * 388;
    LAS float* red = lb + 16;
    const int tid = threadIdx.x, lane = tid & 63, wave = tid >> 6;
    if (tid < 256) qs[tid] = bf2f(Q[(size_t)(MP + b * 4 + (tid >> 6)) * DA + h * 64 + (tid & 63)]);
    __syncthreads();
    const float sl2 = __builtin_amdgcn_exp2f(-(float)(h + 1)) * LOG2E;
    {
        const int sub = tid & 3, grp = tid >> 2;
#pragma unroll 2
        for (int pi = grp; pi < 4 * 387; pi += 128) {
            const int i = pi / 387, rem = pi - i * 387, br = rem / 129, j = rem - br * 129, d = 1 << (2 * br), idx = 2048 + i - d * j;
            const float* kr = idx < 2048 ? sk + ((size_t)(b * 2048 + idx) * 8 + h) * 64 : outp + O_KS + (size_t)(b * 4 + idx - 2048) * DA + h * 64;
            float dot = 0.f;
#pragma unroll
            for (int c4 = 0; c4 < 4; ++c4) { const f32x4 kv = *(const f32x4*)(kr + 16 * c4 + 4 * sub); const LAS float* qq = qs + i * 64 + 16 * c4 + 4 * sub;
                dot += (kv.x * qq[0] + kv.y * qq[1]) + (kv.z * qq[2] + kv.w * qq[3]); }
            dot += __shfl_xor(dot, 1); dot += __shfl_xor(dot, 2);
            if (sub == 0) sb[i * 388 + rem] = dot - sl2 * (float)(d * j);
        }
    }
    __syncthreads();
    if (wave < 4) {
        float v[7], mx = -1e30f;
#pragma unroll
        for (int k = 0; k < 7; ++k) { const int idx = lane + 64 * k; v[k] = idx < 387 ? sb[wave * 388 + idx] : -1e30f; mx = fmaxf(mx, v[k]); }
        mx = wave_max(mx); float s = 0.f;
#pragma unroll
        for (int k = 0; k < 7; ++k) { const int idx = lane + 64 * k; const float p = __builtin_amdgcn_exp2f(v[k] - mx); if (idx < 387) { sb[wave * 388 + idx] = p; s += p; } }
        s = wave_sum(s); if (lane == 0) lb[wave] = s;
    }
    __syncthreads();
    { const int i = tid >> 7, kg = (tid & 127) >> 4, ch = tid & 15; f32x4 acc = {0.f, 0.f, 0.f, 0.f};
#pragma unroll 4
      for (int jj = kg; jj < 387; jj += 8) { const int br = jj / 129, j = jj - br * 129, d = 1 << (2 * br), idx = 2048 + i - d * j;
          const float* vr = idx < 2048 ? sv + ((size_t)(b * 2048 + idx) * 8 + h) * 64 : outp + O_VS + (size_t)(b * 4 + idx - 2048) * DA + h * 64;
          const f32x4 vv = __builtin_nontemporal_load((const f32x4*)(vr + 4 * ch)); acc += vv * sb[i * 388 + jj]; }
      *(LAS f32x4*)(red + (i * 8 + kg) * 64 + 4 * ch) = acc; }
    __syncthreads();
    if (tid < 256) { const int i = tid >> 6, dd = tid & 63; float s = 0.f;
#pragma unroll
        for (int kg = 0; kg < 8; ++kg) s += red[(i * 8 + kg) * 64 + dd];
        MIX[(size_t)(MP + b * 4 + i) * DM + h * 64 + dd] = (bf16)f2bf(s / lb[i]); }
    __syncthreads();
}

__device__ __forceinline__ void unpack8(const u32x4 w, float* f) { f[0] = bflo(w.x); f[1] = bfhi(w.x); f[2] = bflo(w.y); f[3] = bfhi(w.y); f[4] = bflo(w.z); f[5] = bfhi(w.z); f[6] = bflo(w.w); f[7] = bfhi(w.w); }
__device__ __forceinline__ void conv_rows(int vb, int G, const bf16* U, const bf16* Bg, const float* wconv, const float* sconv, bf16* MIX) {
    const int tid = threadIdx.x, rsub = tid >> 6, c8 = (tid & 63) * 8;
    float w0[8], w1[8], w2[8];
#pragma unroll
    for (int e = 0; e < 8; ++e) { w0[e] = wconv[c8 + e]; w1[e] = wconv[512 + c8 + e]; w2[e] = wconv[1024 + c8 + e]; }
    for (int r = vb * 8 + rsub; r < MV; r += G * 8) {
        float u2[8], u1[8], u0[8], gb[8];
        unpack8(*(const u32x4*)(U + (size_t)r * DA + c8), u2); unpack8(__builtin_nontemporal_load((const u32x4*)(Bg + (size_t)r * DA + c8)), gb);
        int i; const float* s1 = nullptr; const float* s0 = nullptr;
        if (r < MP) i = r & 2047;
        else { const int rr = r - MP; i = rr & 3; const float* sc = sconv + (size_t)(rr >> 2) * 1024 + c8; s1 = sc + 512; s0 = sc + (i == 0 ? 0 : 512); }
        if (i >= 1) unpack8(*(const u32x4*)(U + (size_t)(r - 1) * DA + c8), u1);
        else {
#pragma unroll
            for (int e = 0; e < 8; ++e) u1[e] = s1 ? s1[e] : 0.f; }
        if (i >= 2) unpack8(*(const u32x4*)(U + (size_t)(r - 2) * DA + c8), u0);
        else {
#pragma unroll
            for (int e = 0; e < 8; ++e) u0[e] = s0 ? s0[e] : 0.f; }
        float o[8];
#pragma unroll
        for (int e = 0; e < 8; ++e) o[e] = gb[e] * (w0[e] * u0[e] + w1[e] * u1[e] + w2[e] * u2[e]);
        u32x4 w; w.x = pk2(o[0], o[1]); w.y = pk2(o[2], o[3]); w.z = pk2(o[4], o[5]); w.w = pk2(o[6], o[7]);
        *(u32x4*)(MIX + (size_t)r * DM + 512 + c8) = w;
    }
}

template <int NKS  , class Epi>
__device__ __forceinline__ void thin_gemm(LAS unsigned char* lds, int vcu, int G, const bf16* A  , const bf16* Bt, int npn, const Epi& E) {
    constexpr int K = NKS * 128;
    const int tid = threadIdx.x, lane = tid & 63, wave = __builtin_amdgcn_readfirstlane(tid >> 6), r32 = lane & 31, hi = lane >> 5;
    LAS f32x4* red = (LAS f32x4*)lds;
    for (int t = vcu; t < npn * 16; t += G) {
        const int rb = t & 3, c32 = (t >> 2) & 3, pn = t >> 4;
        const bf16* ap = A + (size_t)(32 * rb + r32) * K + wave * (NKS * 16) + 8 * hi;
        const bf16* bp = Bt + (size_t)(256 * pn + 32 * c32 + r32) * K + wave * (NKS * 16) + 8 * hi;
        f32x16 a0, a1;
#pragma unroll
        for (int r = 0; r < 16; ++r) { a0[r] = 0.f; a1[r] = 0.f; }
        constexpr int CH = (NKS == 8) ? 8 : 11;
#pragma unroll
        for (int s0 = 0; s0 < NKS; s0 += CH) {
            bf16x8 af[CH], b0[CH], b1[CH];
#pragma unroll
            for (int s = 0; s < CH; ++s) { af[s] = *(const bf16x8*)(ap + 16 * (s0 + s)); b0[s] = *(const bf16x8*)(bp + 16 * (s0 + s)); b1[s] = *(const bf16x8*)(bp + (size_t)128 * K + 16 * (s0 + s)); }
            __builtin_amdgcn_sched_barrier(0);
#pragma unroll
            for (int s = 0; s < CH; ++s) {
                a0 = __builtin_amdgcn_mfma_f32_32x32x16_bf16(b0[s], af[s], a0, 0, 0, 0);
                a1 = __builtin_amdgcn_mfma_f32_32x32x16_bf16(b1[s], af[s], a1, 0, 0, 0);
            }
            __builtin_amdgcn_sched_barrier(0);
        }
#pragma unroll
        for (int rg = 0; rg < 4; ++rg) {
            red[((wave * 2 + 0) * 4 + rg) * 64 + lane] = (f32x4){a0[4 * rg], a0[4 * rg + 1], a0[4 * rg + 2], a0[4 * rg + 3]};
            red[((wave * 2 + 1) * 4 + rg) * 64 + lane] = (f32x4){a1[4 * rg], a1[4 * rg + 1], a1[4 * rg + 2], a1[4 * rg + 3]};
        }
        __syncthreads();
        if (tid < 256) {
            const int rg = tid >> 6; f32x4 v0 = {0.f, 0.f, 0.f, 0.f}, v1 = {0.f, 0.f, 0.f, 0.f};
#pragma unroll
            for (int w = 0; w < 8; ++w) { v0 += red[((w * 2 + 0) * 4 + rg) * 64 + lane]; v1 += red[((w * 2 + 1) * 4 + rg) * 64 + lane]; }
            E.thin(MP + 32 * rb + r32, pn, 32 * c32 + 8 * rg + 4 * hi, v0, v1);
        }
        __syncthreads();
    }
}

struct Args { const float* in[14]; float* out; unsigned char* ws; };
__global__ void __launch_bounds__(512, 2) fwd_kernel(Args a) {
    extern __shared__ __attribute__((aligned(16))) unsigned char lds_raw[];
    LAS unsigned char* lds = (LAS unsigned char*)lds_raw;
    cg::grid_group grid = cg::this_grid();
    const int tid = threadIdx.x, lane = tid & 63, wave = __builtin_amdgcn_readfirstlane(tid >> 6);
    const int G = gridDim.x, bx = blockIdx.x;
    const int vcu = (G % 8 == 0) ? (bx % 8) * (G / 8) + bx / 8 : bx;
    unsigned char* ws = a.ws;
    const float* x_p = a.in[0]; const float* x_s = a.in[1]; const float* st_k = a.in[2]; const float* st_v = a.in[3]; const float* st_c = a.in[4];
    const float* g_mix = a.in[5]; const float* w_in = a.in[6]; const float* w_conv = a.in[7]; const float* w_out = a.in[8]; const float* g_ffn = a.in[9];
    const float* w_gate = a.in[10]; const float* w_up = a.in[11]; const float* w_down = a.in[12]; const float* g_fin = a.in[13];
    float* out = a.out;
    unsigned long long* ss1 = (unsigned long long*)(ws + WS_SS1); unsigned long long* ss2 = (unsigned long long*)(ws + WS_SS2);
    bf16* Win = (bf16*)(ws + WS_WIN); bf16* Wout = (bf16*)(ws + WS_WOUT); bf16* Wgu = (bf16*)(ws + WS_WGU); bf16* Wdn = (bf16*)(ws + WS_WDN);
    bf16* XN = (bf16*)(ws + WS_XN); bf16* Qb = (bf16*)(ws + WS_Q); bf16* Kb = (bf16*)(ws + WS_K); bf16* Vb = (bf16*)(ws + WS_V);
    bf16* Ub = (bf16*)(ws + WS_U); bf16* Bb = (bf16*)(ws + WS_B); bf16* MIX = (bf16*)(ws + WS_MIX); bf16* ACT = (bf16*)(ws + WS_ACT);

    volatile LAS unsigned* MISC = (volatile LAS unsigned*)(lds + LDS_BYTES - 128);
    if (tid < 32) MISC[tid] = 0u;
    __syncthreads();
    {
        LAS float* scr = (LAS float*)(lds + wave * 16384);
        const int gw = vcu * 8 + wave, NGW = G * 8;
        constexpr int I_IN = 16 * 96, I_OUT = 16 * 32, I_GU = 16 * 176, I_DN = 44 * 32, NITEMS = I_IN + I_OUT + I_GU + I_DN;
        for (int it = gw; it < NITEMS; it += NGW) {
            int r = it;
            if (r < I_IN) { const int kb = r / 96, db = r % 96, rho = 32 * db; int sc;
                if (rho < 1536) sc = rho;
                else if (rho < 2560) { const int j = (rho - 1536) >> 8, w = (rho - 1536) & 255; sc = w < 128 ? 1536 + 128 * j + w : 2560 + 128 * j + (w - 128); }
                else sc = 2048 + (rho - 2560);
                transpose_item(w_in, DIN, DM, Win, rho, sc, kb, scr, lane); continue; }
            r -= I_IN;
            if (r < I_OUT) { const int kb = r / 32, db = r % 32; transpose_item(w_out, DM, DM, Wout, 32 * db, 32 * db, kb, scr, lane); continue; }
            r -= I_OUT;
            if (r < I_GU) { const int kb = r / 176, db = r % 176, rho = 32 * db, pn = rho >> 8, w = rho & 255;
                transpose_item(w < 128 ? w_gate : w_up, DFF, DM, Wgu, rho, 128 * pn + (w & 127), kb, scr, lane); continue; }
            r -= I_GU;
            { const int kb = r / 32, db = r % 32; transpose_item(w_down, DM, DFF, Wdn, 32 * db, 32 * db, kb, scr, lane); }
        }
        for (int m = gw; m < MT; m += 2 * NGW) {
            const int m1 = m + NGW;
            const float* x0 = m < MV ? (m < MP ? x_p + (size_t)m * DM : x_s + (size_t)(m - MP) * DM) : nullptr;
            const float* x1 = m1 < MV ? (m1 < MP ? x_p + (size_t)m1 * DM : x_s + (size_t)(m1 - MP) * DM) : nullptr;
            if (x0) rms_rows2_to_bf16(x0, x1, g_mix, XN + (size_t)m * DM, XN + (size_t)m1 * DM, lane);
        }
    }
    { unsigned long long* ctl = (unsigned long long*)ws; for (int i = bx * 512 + tid; i < (int)(WS_CTL_BYTES / 8); i += G * 512) ctl[i] = 0ull; }
    __syncthreads();
    grid.sync();
    XcdBarrier bar = xcd_barrier_post((unsigned*)(ws + WS_BAR), MISC + 8);

    {
        pg8::Gemm g{XN, Win, MP, DIN, DM}; pg8::StaticOrder S; S.init(MP, DIN, G, bx);
        pg8::EpiIn E{Qb, Kb, Vb, Ub, Bb, out};
        thin_gemm<8>(lds, vcu, G, XN + (size_t)MP * DM, Win, DIN / 256, E);
        pg8::gemm_phase<pg8::EpiIn, pg8::StaticOrder, true, true>(lds, g, S, E);
    }
    xcd_barrier(bar);

    {
        if (vcu & 1) { for (int bh = vcu; bh < 256; bh += G) attn_sample_bh(lds, bh >> 3, bh & 7, Qb, st_k, st_v, out, MIX); }
        attn_prompt_all(lds, vcu, G, Qb, Kb, Vb, MIX);
        if (!(vcu & 1)) { for (int bh = vcu; bh < 256; bh += G) attn_sample_bh(lds, bh >> 3, bh & 7, Qb, st_k, st_v, out, MIX); }
        conv_rows(vcu, G, Ub, Bb, w_conv, st_c, MIX);
    }
    xcd_barrier(bar);

    {
        pg8::Gemm g{MIX, Wout, MP, DM, DM}; pg8::StaticOrder S; S.init(MP, DM, G, bx);
        pg8::EpiOut E{x_p, x_s, out, XN, g_ffn, ss1};
        thin_gemm<8>(lds, vcu, G, MIX + (size_t)MP * DM, Wout, DM / 256, E);
        pg8::gemm_phase<pg8::EpiOut, pg8::StaticOrder, true, true>(lds, g, S, E);
    }
    xcd_barrier(bar);

    {
        pg8::Gemm g{XN, Wgu, MP, 2 * DFF, DM}; pg8::StaticOrder S; S.init(MP, 2 * DFF, G, bx);
        pg8::EpiGU E{ACT, ss1};
        thin_gemm<8>(lds, vcu, G, XN + (size_t)MP * DM, Wgu, 2 * DFF / 256, E);
        pg8::gemm_phase<pg8::EpiGU, pg8::StaticOrder, true, true>(lds, g, S, E);
    }
    xcd_barrier(bar);

    {
        pg8::Gemm g{ACT, Wdn, MP, DM, DFF}; pg8::StaticOrder S; S.init(MP, DM, G, bx);
        pg8::EpiDown E{out, ss2, XN, g_ffn, g_fin};
        thin_gemm<22>(lds, vcu, G, ACT + (size_t)MP * DFF, Wdn, DM / 256, E);
        pg8::gemm_phase<pg8::EpiDown, pg8::StaticOrder, true, true>(lds, g, S, E);
    }
}

extern "C" void kernel_launch(void* const* d_in, const int* in_sizes, int n_in, void* d_out, int out_size, void* d_ws, size_t ws_size, hipStream_t stream) {
    static int grid = 0;
    if (grid == 0) {
        if (n_in != 14 || (size_t)out_size != O_END || ws_size < WS_END) { fprintf(stderr, "kernel_launch: unexpected shapes (n_in %d, out %d, ws %zu)\n", n_in, out_size, ws_size); grid = -1; return; }
        int dev = 0, cus = 0, per_cu = 0;
        hipGetDevice(&dev); hipDeviceGetAttribute(&cus, hipDeviceAttributeMultiprocessorCount, dev);
        if (hipFuncSetAttribute((const void*)fwd_kernel, hipFuncAttributeMaxDynamicSharedMemorySize, LDS_BYTES) != hipSuccess) { fprintf(stderr, "kernel_launch: hipFuncSetAttribute failed\n"); grid = -1; return; }
        if (hipOccupancyMaxActiveBlocksPerMultiprocessor(&per_cu, (const void*)fwd_kernel, 512, LDS_BYTES) != hipSuccess || per_cu < 1) { fprintf(stderr, "kernel_launch: occupancy query gave %d\n", per_cu); per_cu = 1; }
        (void)hipGetLastError();
        grid = cus * 1;
        if (grid <= 0) grid = 256;
    }
    if (grid < 0) return;
    Args a{};
    for (int i = 0; i < 14; ++i) a.in[i] = (const float*)d_in[i];
    a.out = (float*)d_out; a.ws = (unsigned char*)d_ws;
    void* args[] = {&a};
    hipError_t e = hipLaunchCooperativeKernel((const void*)fwd_kernel, dim3(grid), dim3(512), args, LDS_BYTES, stream);
    if (e != hipSuccess) fprintf(stderr, "cooperative launch failed: %s (grid %d)\n", hipGetErrorString(e), grid);
}
```
